# Optimizing an MI355X kernel written in HIP

```python
import jax, jax.numpy as jnp
from jax import lax
import numpy as np

D_MODEL = 2048
BATCH = 1
SEQ = 16384
DEPTH = 1

CHUNK = 64
EPS = 1e-6
CONV_WIDTH = D_MODEL // 2
CONV_GROUPS = 16
CONV_K = 3
SSD_WIDTH = D_MODEL // 2
SSD_HEAD_DIM = 64
SSD_HEADS = SSD_WIDTH // SSD_HEAD_DIM
SSD_GROUPS = 2
SSD_HEADS_PER_GROUP = SSD_HEADS // SSD_GROUPS
SSD_STATE = 128
SSD_CONV_K = 4
SSD_XBC = SSD_WIDTH + 2 * SSD_GROUPS * SSD_STATE
MIX_WIDTH = CONV_WIDTH + SSD_WIDTH
IN_COLS = 3 * CONV_WIDTH + SSD_WIDTH + SSD_XBC + SSD_HEADS
N_EXPERT_GROUPS = 4
EXPERTS_PER_GROUP = 8
N_EXPERTS = N_EXPERT_GROUPS * EXPERTS_PER_GROUP
TOP_K = 2
D_FF_EXPERT = D_MODEL // 2
MOE_BLOCK = 128

kernel_name = "hybrid_conv_ssd_hmoe_block"


def rmsnorm(x, w):
    xf = x.astype(jnp.float32)
    y = xf * lax.rsqrt(jnp.mean(xf * xf, axis=-1, keepdims=True) + EPS)
    return (y * w.astype(jnp.float32)).astype(x.dtype)


def causal_dwconv(x, w):
    k, ch = w.shape
    return lax.conv_general_dilated(
        x, w[:, None, :].astype(x.dtype), window_strides=(1,), padding=[(k - 1, 0)],
        dimension_numbers=('NWC', 'WIO', 'NWC'), feature_group_count=ch)


def short_conv_mixer(u, conv_w):
    b_gate, c_gate, v = jnp.split(u, 3, axis=-1)
    return b_gate * causal_dwconv(c_gate * v, conv_w)


def segsum_exp(a):
    q = a.shape[-1]
    cs = jnp.cumsum(a, axis=-1)
    diff = cs[..., :, None] - cs[..., None, :]
    mask = jnp.tril(jnp.ones((q, q), dtype=bool))
    return jnp.where(mask, jnp.exp(jnp.where(mask, diff, 0.0)), 0.0)


def ssd_mixer(u_z, u_xbc, u_dt, conv_w, conv_b, dt_bias, a_log, d_skip, norm_w):
    bsz, seq_len, _ = u_z.shape
    nc = seq_len // CHUNK
    g, r, p, n = SSD_GROUPS, SSD_HEADS_PER_GROUP, SSD_HEAD_DIM, SSD_STATE
    f32 = jnp.float32
    xbc = jax.nn.silu(causal_dwconv(u_xbc, conv_w) + conv_b).astype(f32)
    xs, bm, cm = jnp.split(xbc, [SSD_WIDTH, SSD_WIDTH + g * n], axis=-1)
    xs = xs.reshape(bsz, nc, CHUNK, g, r, p)
    bm = bm.reshape(bsz, nc, CHUNK, g, n)
    cm = cm.reshape(bsz, nc, CHUNK, g, n)
    dt = jax.nn.softplus(u_dt.astype(f32) + dt_bias.astype(f32))
    a_head = -jnp.exp(a_log.astype(f32))
    dt_r = dt.reshape(bsz, nc, CHUNK, g, r)
    a = (dt * a_head).reshape(bsz, nc, CHUNK, g, r).transpose(0, 3, 4, 1, 2)
    xd = xs * dt_r[..., None]
    a_cs = jnp.cumsum(a, axis=-1)
    cb = jnp.einsum('bclgn,bcsgn->bgcls', cm, bm)
    m = cb[:, :, None] * segsum_exp(a)
    y_diag = jnp.einsum('bgrcls,bcsgrp->bclgrp', m, xd)
    decay_states = jnp.exp(a_cs[..., -1:] - a_cs).transpose(0, 3, 4, 1, 2)
    states = jnp.einsum('bclgn,bclgrp->bcgrpn', bm, xd * decay_states[..., None])
    chunk_decay = jnp.exp(a_cs[..., -1])

    def step(h, inp):
        dec, s = inp
        return h * dec[..., None, None] + s, h

    h0 = jnp.zeros((bsz, g, r, p, n), f32)
    _, prev = lax.scan(step, h0, (jnp.moveaxis(chunk_decay, -1, 0), jnp.moveaxis(states, 1, 0)))
    prev = jnp.moveaxis(prev, 0, 1)
    state_decay = jnp.exp(a_cs).transpose(0, 3, 4, 1, 2)
    y_off = jnp.einsum('bclgn,bcgrpn->bclgrp', cm, prev) * state_decay[..., None]
    y = y_diag + y_off + xs * d_skip.astype(f32).reshape(g, r, 1)
    y = y.reshape(bsz, seq_len, SSD_WIDTH)
    yg = (y * jax.nn.silu(u_z.astype(f32))).reshape(bsz, seq_len, g, SSD_WIDTH // g)
    yg = yg * lax.rsqrt(jnp.mean(yg * yg, axis=-1, keepdims=True) + EPS)
    yg = yg.reshape(bsz, seq_len, SSD_WIDTH) * norm_w.astype(f32)
    return yg.astype(u_z.dtype)


def hier_moe(h, w_rg, b_rg, w_re, b_re, w_gate, w_up, w_down):
    bsz, seq_len, d = h.shape
    t = bsz * seq_len
    ht = h.reshape(t, d)
    grp_prob = jax.nn.softmax((ht @ w_rg + b_rg).astype(jnp.float32), axis=-1)
    grp_p, grp_idx = lax.top_k(grp_prob, 1)
    exp_logits = (ht @ w_re + b_re).astype(jnp.float32).reshape(t, N_EXPERT_GROUPS, EXPERTS_PER_GROUP)
    in_grp = exp_logits[jnp.arange(t), grp_idx[:, 0]]
    top_p, top_local = lax.top_k(jax.nn.softmax(in_grp, axis=-1), TOP_K)
    weights = grp_p * (top_p / jnp.sum(top_p, axis=-1, keepdims=True))
    expert_ids = grp_idx * EXPERTS_PER_GROUP + top_local
    n_assign = t * TOP_K
    e_flat = expert_ids.reshape(n_assign)
    w_flat = weights.reshape(n_assign)
    tok_flat = jnp.repeat(jnp.arange(t, dtype=jnp.int32), TOP_K)
    order = jnp.argsort(e_flat)
    e_sorted = e_flat[order]
    counts = jnp.bincount(e_flat, length=N_EXPERTS)
    padded = ((counts + MOE_BLOCK - 1) // MOE_BLOCK) * MOE_BLOCK
    start = jnp.cumsum(counts) - counts
    padded_end = jnp.cumsum(padded)
    pstart = padded_end - padded
    dest = pstart[e_sorted] + (jnp.arange(n_assign) - start[e_sorted])
    n_blocks = (n_assign + N_EXPERTS * (MOE_BLOCK - 1) + MOE_BLOCK - 1) // MOE_BLOCK
    n_slots = n_blocks * MOE_BLOCK
    slot_tok = jnp.zeros((n_slots,), jnp.int32).at[dest].set(tok_flat[order])
    slot_w = jnp.zeros((n_slots,), jnp.float32).at[dest].set(w_flat[order])
    block_exp = jnp.minimum(
        jnp.searchsorted(padded_end, jnp.arange(n_blocks) * MOE_BLOCK, side='right'), N_EXPERTS - 1)
    tok_blocks = slot_tok.reshape(n_blocks, MOE_BLOCK)
    w_blocks = slot_w.reshape(n_blocks, MOE_BLOCK)

    def run_block(args):
        toks, wts, e = args
        xb = ht[toks]
        hid = jax.nn.silu(xb @ w_gate[e]) * (xb @ w_up[e])
        yb = hid @ w_down[e]
        return (yb * wts[:, None]).astype(h.dtype)

    yb = lax.map(run_block, (tok_blocks, w_blocks, block_exp))
    out = jnp.zeros((t, d), h.dtype).at[slot_tok].add(yb.reshape(n_slots, d))
    return out.reshape(bsz, seq_len, d)


def setup_inputs(seed: int = 0) -> dict:
    key = jax.random.key(seed)
    ks = jax.random.split(key, 24)
    nrm = jax.random.normal
    L, D = DEPTH, D_MODEL
    dt0 = jnp.exp(jax.random.uniform(ks[9], (L, SSD_HEADS), minval=np.log(1e-3), maxval=np.log(1e-1)))
    return {
        "x": nrm(ks[0], (BATCH, SEQ, D), jnp.float32),
        "c": nrm(ks[1], (BATCH, D), jnp.float32),
        "w_ada": nrm(ks[2], (L, D, 6 * D)) * (0.5 * D ** -0.5),
        "b_ada": nrm(ks[3], (L, 6 * D)) * 0.02,
        "norm1_w": 1.0 + 0.02 * nrm(ks[4], (L, D)),
        "w_in": nrm(ks[5], (L, D, IN_COLS)) * D ** -0.5,
        "conv_w": nrm(ks[6], (L, CONV_K, CONV_WIDTH)) * CONV_K ** -0.5,
        "ssd_conv_w": nrm(ks[7], (L, SSD_CONV_K, SSD_XBC)) * SSD_CONV_K ** -0.5,
        "ssd_conv_b": nrm(ks[8], (L, SSD_XBC)) * 0.01,
        "dt_bias": dt0 + jnp.log(-jnp.expm1(-dt0)),
        "a_log": jnp.log(jax.random.uniform(ks[10], (L, SSD_HEADS), minval=1.0, maxval=16.0)),
        "d_skip": 1.0 + 0.02 * nrm(ks[11], (L, SSD_HEADS)),
        "ssd_norm_w": 1.0 + 0.02 * nrm(ks[12], (L, SSD_WIDTH)),
        "w_out": nrm(ks[13], (L, MIX_WIDTH, D)) * MIX_WIDTH ** -0.5,
        "norm2_w": 1.0 + 0.02 * nrm(ks[14], (L, D)),
        "w_router_grp": nrm(ks[15], (L, D, N_EXPERT_GROUPS)) * D ** -0.5,
        "b_router_grp": nrm(ks[16], (L, N_EXPERT_GROUPS)) * 0.01,
        "w_router_exp": nrm(ks[17], (L, D, N_EXPERTS)) * D ** -0.5,
        "b_router_exp": nrm(ks[18], (L, N_EXPERTS)) * 0.01,
        "w_gate": nrm(ks[19], (L, N_EXPERTS, D, D_FF_EXPERT)) * D ** -0.5,
        "w_up": nrm(ks[20], (L, N_EXPERTS, D, D_FF_EXPERT)) * D ** -0.5,
        "w_down": nrm(ks[21], (L, N_EXPERTS, D_FF_EXPERT, D)) * D_FF_EXPERT ** -0.5,
        "final_norm_w": 1.0 + 0.02 * nrm(ks[22], (D,)),
    }


def reference(x, c, w_ada, b_ada, norm1_w, w_in, conv_w, ssd_conv_w, ssd_conv_b, dt_bias,
              a_log, d_skip, ssd_norm_w, w_out, norm2_w, w_router_grp, b_router_grp,
              w_router_exp, b_router_exp, w_gate, w_up, w_down, final_norm_w):
    split_pts = [3 * CONV_WIDTH, 3 * CONV_WIDTH + SSD_WIDTH, 3 * CONV_WIDTH + SSD_WIDTH + SSD_XBC]
    for i in range(DEPTH):
        mod = jax.nn.silu(c) @ w_ada[i] + b_ada[i]
        sh1, sc1, g1, sh2, sc2, g2 = jnp.split(mod[:, None, :], 6, axis=-1)
        h = rmsnorm(x, norm1_w[i]) * (1 + sc1) + sh1
        u = h @ w_in[i]
        u_conv, u_z, u_xbc, u_dt = jnp.split(u, split_pts, axis=-1)
        y_conv = short_conv_mixer(u_conv, conv_w[i])
        y_ssd = ssd_mixer(u_z, u_xbc, u_dt, ssd_conv_w[i], ssd_conv_b[i], dt_bias[i],
                          a_log[i], d_skip[i], ssd_norm_w[i])
        x = x + g1 * (jnp.concatenate([y_conv, y_ssd], axis=-1) @ w_out[i])
        h = rmsnorm(x, norm2_w[i]) * (1 + sc2) + sh2
        x = x + g2 * hier_moe(h, w_router_grp[i], b_router_grp[i], w_router_exp[i],
                              b_router_exp[i], w_gate[i], w_up[i], w_down[i])
    return rmsnorm(x, final_norm_w)
```

```cpp
#include <hip/hip_runtime.h>
#include <cstdio>
#include <cstdint>

#ifndef MK_N_LAUNCHES
#define MK_N_LAUNCHES 1
#endif

namespace pg8 {
#define PG8_LAS __attribute__((address_space(3)))
typedef unsigned short bf16_t;
typedef short bf16x8 __attribute__((ext_vector_type(8)));
typedef float f32x4 __attribute__((ext_vector_type(4)));
typedef unsigned u32x4 __attribute__((ext_vector_type(4)));
constexpr int BM = 256, BK = 64, HALF = 128, HTB = HALF * BK * 2  , STAGE_BYTES = 8 * HTB, NXCD = 8, WGM = 8;

__host__ __device__ __forceinline__ int lds_byte(int r, int c) { const int st = (r >> 4) * 2 + (c >> 5), rr = r & 15, cc = c & 31, ob = rr * 64 + cc * 2; return st * 1024 + (ob ^ (((ob >> 9) & 1) << 5)); }
__host__ __device__ __forceinline__ void stage_rc(int b, int& R, int& C) { const int st = b / 1024, sb = b % 1024, swz = sb ^ (((sb >> 9) & 1) << 5); R = (st >> 1) * 16 + swz / 64; C = (st & 1) * 32 + (swz % 64) / 2; }
__host__ __device__ __forceinline__ int perm32(int rho) { const int n = rho >> 4, i = rho & 15; return 8 * (i >> 2) + 4 * n + (i & 3); }

struct Unit { int pm, pn, pb, pe; };
struct Gemm { const bf16_t* A; const bf16_t* Bt; int M, N, K; size_t estep; };

struct StaticOrder {
    int nM, nN, nwg, G, c;
    __host__ __device__ void init(int M, int N, int G_, int c_) { nM = M / BM; nN = N / BM; nwg = nM * nN; G = G_; c = c_; }
    __host__ __device__ bool next(int i, Unit& u) const {
        const long L = (long)i * G + c; if (L >= nwg) return false;
        int wgid = (int)L; { const int q = nwg / NXCD, r = nwg % NXCD, xcd = wgid % NXCD, off = wgid / NXCD; wgid = (xcd < r ? xcd * (q + 1) : r * (q + 1) + (xcd - r) * q) + off; }
        const int nig = WGM * nN, gid = wgid / nig, fm = gid * WGM, gsz = (nM - fm) < WGM ? (nM - fm) : WGM;
        u.pm = fm + ((wgid % nig) % gsz); u.pn = (wgid % nig) / gsz; u.pb = u.pn; u.pe = 0; return true;
    }
    __device__ __forceinline__ void a_ready(const Unit&) const {}
    __device__ __forceinline__ void done(const Unit&, int) const {}
};
struct MoeOrder {
    const int* tile_e; int nunits, ncol, G, c;
    __device__ bool next(int i, Unit& u) const {
        const long L = (long)i * G + c; if (L >= nunits) return false;
        u.pm = (int)L / ncol; u.pn = (int)L % ncol;
        const int e = __builtin_amdgcn_readfirstlane(__hip_atomic_load((int*)tile_e + u.pm, __ATOMIC_RELAXED, __HIP_MEMORY_SCOPE_AGENT));
        u.pb = u.pn; u.pe = e; return true;
    }
    __device__ __forceinline__ void a_ready(const Unit&) const {}
    __device__ __forceinline__ void done(const Unit&, int) const {}
};

typedef float f32x2_t __attribute__((ext_vector_type(2)));
typedef __bf16 bf16x2_t __attribute__((ext_vector_type(2)));
__device__ __forceinline__ unsigned cvt_pk_bf16(float lo, float hi) { const f32x2_t v = {lo, hi}; const bf16x2_t b = __builtin_convertvector(v, bf16x2_t); return __builtin_bit_cast(unsigned, b); }

struct EpiU {
    static constexpr bool PERM = true, AFTER_DRAIN = false;
    bf16_t* U; float* udt;
    __device__ __forceinline__ void operator()(const f32x4 (&acc)[2][2][4][2], const Unit& u, int wr, int wc, int fr, int fq) const {
        const int row0 = u.pm * BM + wr * 64 + fr;
        if (u.pn < 22) {
            const int col0 = u.pn * BM + wc * 32 + 8 * fq;
#pragma unroll
            for (int ai = 0; ai < 2; ++ai)
#pragma unroll
                for (int m = 0; m < 4; ++m) { bf16_t* rowp = U + (size_t)(row0 + ai * HALF + m * 16) * 5632 + col0;
#pragma unroll
                    for (int bj = 0; bj < 2; ++bj) { const f32x4 v0 = acc[ai][bj][m][0], v1 = acc[ai][bj][m][1];
                        u32x4 w; w.x = cvt_pk_bf16(v0[0], v0[1]); w.y = cvt_pk_bf16(v0[2], v0[3]); w.z = cvt_pk_bf16(v1[0], v1[1]); w.w = cvt_pk_bf16(v1[2], v1[3]);
                        *(u32x4*)(rowp + bj * HALF) = w; } }
        } else if (wc == 0 && fq < 2) {
#pragma unroll
            for (int ai = 0; ai < 2; ++ai)
#pragma unroll
                for (int m = 0; m < 4; ++m) { float* rowp = udt + (size_t)(row0 + ai * HALF + m * 16) * 16 + 8 * fq;
                    *(f32x4*)(rowp) = acc[ai][0][m][0]; *(f32x4*)(rowp + 4) = acc[ai][0][m][1]; }
        }
    }
};
struct EpiX1 {
    static constexpr bool PERM = false, AFTER_DRAIN = false;
    const float* X; float* O; const float* gate;
    __device__ __forceinline__ void operator()(const f32x4 (&acc)[2][2][4][2], const Unit& u, int wr, int wc, int fr, int fq) const {
        const int row0 = u.pm * BM + wr * 64 + fr, col0 = u.pn * BM + wc * 32 + 4 * fq;
        f32x4 gv[2][2];
#pragma unroll
        for (int bj = 0; bj < 2; ++bj)
#pragma unroll
            for (int n = 0; n < 2; ++n) gv[bj][n] = *(const f32x4*)(gate + col0 + bj * HALF + n * 16);
#pragma unroll
        for (int ai = 0; ai < 2; ++ai)
#pragma unroll
            for (int m = 0; m < 4; ++m) { const size_t ro = (size_t)(row0 + ai * HALF + m * 16) * 2048 + col0;
#pragma unroll
                for (int bj = 0; bj < 2; ++bj)
#pragma unroll
                    for (int n = 0; n < 2; ++n) { const f32x4 xv = *(const f32x4*)(X + ro + bj * HALF + n * 16);
                        *(f32x4*)(O + ro + bj * HALF + n * 16) = xv + gv[bj][n] * acc[ai][bj][m][n]; } }
    }
};
struct EpiHid {
    static constexpr bool PERM = true, AFTER_DRAIN = false;
    bf16_t* Hd;
    __device__ __forceinline__ void operator()(const f32x4 (&acc)[2][2][4][2], const Unit& u, int wr, int wc, int fr, int fq) const {
        const int row0 = u.pm * BM + wr * 64 + fr, col0 = u.pn * HALF + wc * 32 + 8 * fq;
#pragma unroll
        for (int ai = 0; ai < 2; ++ai)
#pragma unroll
            for (int m = 0; m < 4; ++m) { bf16_t* rowp = Hd + (size_t)(row0 + ai * HALF + m * 16) * 1024 + col0;
                float r[8];
#pragma unroll
                for (int n = 0; n < 2; ++n)
#pragma unroll
                    for (int j = 0; j < 4; ++j) { const float g = acc[ai][0][m][n][j], up = acc[ai][1][m][n][j]; r[4 * n + j] = g / (1.f + __expf(-g)) * up; }
                u32x4 w; w.x = cvt_pk_bf16(r[0], r[1]); w.y = cvt_pk_bf16(r[2], r[3]); w.z = cvt_pk_bf16(r[4], r[5]); w.w = cvt_pk_bf16(r[6], r[7]);
                *(u32x4*)(rowp) = w; }
    }
};
struct EpiY {
    static constexpr bool PERM = true, AFTER_DRAIN = false;
    bf16_t* Y;
    __device__ __forceinline__ void operator()(const f32x4 (&acc)[2][2][4][2], const Unit& u, int wr, int wc, int fr, int fq) const {
        const int row0 = u.pm * BM + wr * 64 + fr, col0 = u.pn * BM + wc * 32 + 8 * fq;
#pragma unroll
        for (int ai = 0; ai < 2; ++ai)
#pragma unroll
            for (int m = 0; m < 4; ++m) { bf16_t* rowp = Y + (size_t)(row0 + ai * HALF + m * 16) * 2048 + col0;
#pragma unroll
                for (int bj = 0; bj < 2; ++bj) { const f32x4 v0 = acc[ai][bj][m][0], v1 = acc[ai][bj][m][1];
                    u32x4 w; w.x = cvt_pk_bf16(v0[0], v0[1]); w.y = cvt_pk_bf16(v0[2], v0[3]); w.z = cvt_pk_bf16(v1[0], v1[1]); w.w = cvt_pk_bf16(v1[2], v1[3]);
                    *(u32x4*)(rowp + bj * HALF) = w; } }
    }
};

template <class Epi, class Sched, bool ALIGN_EPI = false, bool SP2 = false, bool BK8 = false>
__device__ __forceinline__ void gemm_phase(PG8_LAS unsigned char* lds, const Gemm g, const Sched& S, const Epi& E) {
    const int tid = threadIdx.x, wid = __builtin_amdgcn_readfirstlane(tid >> 6), lane = tid & 63, wr = wid >> 2, wc = wid & 3, fr = lane & 15, fq = lane >> 4;
    const int K = g.K, nt = K / BK;
    unsigned voffA[2], voffB[2];
#pragma unroll
    for (int i = 0; i < 2; ++i) { int R, C; stage_rc(tid * 16 + i * 8192, R, C); const int Rb = Epi::PERM ? ((R & ~31) + perm32(R & 31)) : R;
        voffA[i] = (unsigned)(R * K + C) * 2u; voffB[i] = BK8 ? (unsigned)((C >> 3) * g.N + Rb) * 16u : (unsigned)(Rb * K + C) * 2u; }
    const size_t kstepA = (size_t)(BK * 2), hstepA = (size_t)HALF * K * 2, tstepA = 2 * hstepA;
    const size_t kstepB = BK8 ? (size_t)128 * g.N : (size_t)(BK * 2), hstepB = BK8 ? (size_t)2048 : (size_t)HALF * K * 2;
#define PG8_BBASE(u) ((const char*)g.Bt + (BK8 ? (size_t)(u).pe * g.estep + (size_t)(u).pb * 4096 : (size_t)(u).pb * 2 * hstepB))
    const unsigned ldsw = (unsigned)wid * 1024u;
    const int aoff = lds_byte(wr * 64 + fr, fq * 8), boff = lds_byte(wc * 32 + fr, fq * 8);
#define PG8_SA(b, h) (((b) * 2 + (h)) * HTB)
#define PG8_SB(b, h) ((4 + (b) * 2 + (h)) * HTB)
#define PG8_STAGE(bufoff, gbase, voff) do { _Pragma("unroll") for (int _i = 0; _i < 2; ++_i) \
        __builtin_amdgcn_global_load_lds((const unsigned*)((const char*)(gbase) + (voff)[_i]), (PG8_LAS unsigned*)(lds + (bufoff) + ldsw + _i * 8192), 16, 0, 0); } while (0)
#define PG8_LDA(dst, b, h) do { _Pragma("unroll") for (int m = 0; m < 4; ++m) _Pragma("unroll") for (int k = 0; k < 2; ++k) dst[m][k] = *(const PG8_LAS bf16x8*)(lds + PG8_SA(b, h) + aoff + m * 2048 + k * 1024); } while (0)
#define PG8_LDB(dst, b, h) do { _Pragma("unroll") for (int n = 0; n < 2; ++n) _Pragma("unroll") for (int k = 0; k < 2; ++k) dst[n][k] = *(const PG8_LAS bf16x8*)(lds + PG8_SB(b, h) + boff + n * 2048 + k * 1024); } while (0)
#define PG8_MMA(ai, bj, At, Bt) do { __builtin_amdgcn_s_setprio(1); _Pragma("unroll") for (int m = 0; m < 4; ++m) _Pragma("unroll") for (int n = 0; n < 2; ++n) _Pragma("unroll") for (int k = 0; k < 2; ++k) \
        acc[ai][bj][m][n] = __builtin_amdgcn_mfma_f32_16x16x32_bf16(Bt[n][k], At[m][k], acc[ai][bj][m][n], 0, 0, 0); __builtin_amdgcn_s_setprio(0); } while (0)
#define PG8_WAIT_V(n) asm volatile("s_waitcnt vmcnt(" #n ")" ::: "memory")
#define PG8_WAIT_L(n) asm volatile("s_waitcnt lgkmcnt(" #n ")" ::: "memory")
#define PG8_BAR __builtin_amdgcn_s_barrier()
#define PG8_SCHED __builtin_amdgcn_sched_barrier(0)
    Unit cur, nxt; int ui = 0;
    if (!S.next(0, cur)) return;
    f32x4 acc[2][2][4][2];
#pragma unroll
    for (int a = 0; a < 2; ++a)
#pragma unroll
        for (int b = 0; b < 2; ++b)
#pragma unroll
            for (int m = 0; m < 4; ++m)
#pragma unroll
                for (int n = 0; n < 2; ++n) acc[a][b][m][n] = (f32x4){0.f, 0.f, 0.f, 0.f};
    bf16x8 At[4][2], B0[2][2], B1[2][2];
    const char* cA = (const char*)g.A + (size_t)cur.pm * tstepA; const char* cB = PG8_BBASE(cur);
    S.a_ready(cur);
    if constexpr (SP2) {
        PG8_STAGE(PG8_SB(0, 0), cB, voffB); PG8_STAGE(PG8_SB(0, 1), cB + hstepB, voffB); PG8_STAGE(PG8_SA(0, 0), cA, voffA); PG8_STAGE(PG8_SA(0, 1), cA + hstepA, voffA);
        if (wr == 1) PG8_BAR;
        PG8_WAIT_V(2); PG8_BAR;
        PG8_STAGE(PG8_SB(1, 0), cB + kstepB, voffB); PG8_STAGE(PG8_SA(1, 0), cA + kstepA, voffA); PG8_STAGE(PG8_SB(1, 1), cB + hstepB + kstepB, voffB);
        PG8_WAIT_V(6); PG8_BAR;
    } else {
        PG8_STAGE(PG8_SB(0, 0), cB, voffB); PG8_STAGE(PG8_SA(0, 0), cA, voffA); PG8_STAGE(PG8_SB(0, 1), cB + hstepB, voffB); PG8_STAGE(PG8_SA(0, 1), cA + hstepA, voffA);
        if (wr == 1) PG8_BAR;
        PG8_WAIT_V(4); PG8_BAR;
        PG8_STAGE(PG8_SB(1, 0), cB + kstepB, voffB); PG8_STAGE(PG8_SA(1, 0), cA + kstepA, voffA); PG8_STAGE(PG8_SB(1, 1), cB + hstepB + kstepB, voffB);
        PG8_WAIT_V(6); PG8_BAR;
    }
    for (;;) {
        const bool has_next = S.next(ui + 1, nxt);
        const char* nA = has_next ? (const char*)g.A + (size_t)nxt.pm * tstepA : cA; const char* nB = has_next ? PG8_BBASE(nxt) : cB;
        for (int t = 0; t < nt; t += 2) {
            const bool last = (t == nt - 2);
            const char* a1 = cA + (size_t)(t + 1) * kstepA;
            const char* a2 = last ? nA : cA + (size_t)(t + 2) * kstepA; const char* b2 = last ? nB : cB + (size_t)(t + 2) * kstepB;
            const char* a3 = a2 + kstepA; const char* b3 = b2 + kstepB;
            if (last && has_next) S.a_ready(nxt);
            if constexpr (SP2) {
            PG8_LDB(B0, 0, 0); PG8_LDB(B1, 0, 1); PG8_SCHED; PG8_LDA(At, 0, 0); PG8_STAGE(PG8_SA(1, 1), a1 + hstepA, voffA);
            PG8_WAIT_V(8); PG8_WAIT_L(0); PG8_BAR; PG8_MMA(0, 0, At, B0); PG8_MMA(0, 1, At, B1); PG8_BAR; PG8_SCHED;
            PG8_LDA(At, 0, 1); PG8_STAGE(PG8_SB(0, 0), b2, voffB); PG8_STAGE(PG8_SB(0, 1), b2 + hstepB, voffB); PG8_STAGE(PG8_SA(0, 0), a2, voffA);
            PG8_WAIT_V(8); PG8_WAIT_L(0); PG8_BAR; PG8_MMA(1, 0, At, B0); PG8_MMA(1, 1, At, B1); PG8_BAR; PG8_SCHED;
            PG8_LDB(B0, 1, 0); PG8_LDB(B1, 1, 1); PG8_SCHED; PG8_LDA(At, 1, 0); PG8_STAGE(PG8_SA(0, 1), a2 + hstepA, voffA);
            PG8_WAIT_V(8); PG8_WAIT_L(0); PG8_BAR; PG8_MMA(0, 0, At, B0); PG8_MMA(0, 1, At, B1); PG8_BAR; PG8_SCHED;
            PG8_LDA(At, 1, 1); PG8_STAGE(PG8_SB(1, 0), b3, voffB); PG8_STAGE(PG8_SB(1, 1), b3 + hstepB, voffB); PG8_STAGE(PG8_SA(1, 0), a3, voffA);
            PG8_WAIT_V(8); PG8_WAIT_L(0); PG8_BAR; PG8_MMA(1, 0, At, B0); PG8_MMA(1, 1, At, B1); PG8_BAR; PG8_SCHED;
            } else {
            PG8_LDB(B0, 0, 0); PG8_SCHED; PG8_LDA(At, 0, 0); PG8_STAGE(PG8_SA(1, 1), a1 + hstepA, voffA);
            PG8_WAIT_L(8); PG8_BAR; PG8_WAIT_L(0); PG8_MMA(0, 0, At, B0); PG8_BAR; PG8_SCHED;
            PG8_LDB(B1, 0, 1); PG8_STAGE(PG8_SB(0, 0), b2, voffB);
            PG8_BAR; PG8_WAIT_L(0); PG8_MMA(0, 1, At, B1); PG8_BAR;
            PG8_LDA(At, 0, 1); PG8_STAGE(PG8_SA(0, 0), a2, voffA);
            PG8_BAR; PG8_WAIT_L(0); PG8_MMA(1, 0, At, B0); PG8_BAR; PG8_SCHED;
            PG8_STAGE(PG8_SB(0, 1), b2 + hstepB, voffB);
            PG8_WAIT_V(6); PG8_BAR; PG8_MMA(1, 1, At, B1); PG8_BAR;
            PG8_LDB(B0, 1, 0); PG8_SCHED; PG8_LDA(At, 1, 0); PG8_STAGE(PG8_SA(0, 1), a2 + hstepA, voffA);
            PG8_WAIT_L(8); PG8_BAR; PG8_WAIT_L(0); PG8_MMA(0, 0, At, B0); PG8_BAR; PG8_SCHED;
            PG8_LDB(B1, 1, 1); PG8_STAGE(PG8_SB(1, 0), b3, voffB);
            PG8_BAR; PG8_WAIT_L(0); PG8_MMA(0, 1, At, B1); PG8_BAR;
            PG8_LDA(At, 1, 1); PG8_STAGE(PG8_SA(1, 0), a3, voffA);
            PG8_BAR; PG8_WAIT_L(0); PG8_MMA(1, 0, At, B0); PG8_BAR; PG8_SCHED;
            PG8_STAGE(PG8_SB(1, 1), b3 + hstepB, voffB);
            PG8_WAIT_V(6); PG8_BAR; PG8_MMA(1, 1, At, B1); PG8_BAR;
            }
        }
        if constexpr (ALIGN_EPI) { if (wr == 0) PG8_BAR; }
        if constexpr (!Epi::AFTER_DRAIN) { E(acc, cur, wr, wc, fr, fq); S.done(cur, ui); }
        if (!has_next) break;
#pragma unroll
        for (int a = 0; a < 2; ++a)
#pragma unroll
            for (int b = 0; b < 2; ++b)
#pragma unroll
                for (int m = 0; m < 4; ++m)
#pragma unroll
                    for (int n = 0; n < 2; ++n) acc[a][b][m][n] = (f32x4){0.f, 0.f, 0.f, 0.f};
        cur = nxt; cA = nA; cB = nB; ++ui;
        if constexpr (ALIGN_EPI) { if (wr == 1) PG8_BAR; }
    }
    PG8_WAIT_V(0);
    if constexpr (!ALIGN_EPI) { if (wr == 0) PG8_BAR; }
    PG8_BAR;
    if constexpr (Epi::AFTER_DRAIN) { E.fused(acc, cur, wr, wc, fr, fq, lds, wid, lane); S.done(cur, ui); }
#undef PG8_BBASE
#undef PG8_SA
#undef PG8_SB
#undef PG8_STAGE
#undef PG8_LDA
#undef PG8_LDB
#undef PG8_MMA
#undef PG8_WAIT_V
#undef PG8_WAIT_L
#undef PG8_BAR
#undef PG8_SCHED
}
}
#define XB_TMO      128
#define XB_XCNT(j)  (256  + 64 * (j))
#define XB_XSUB(j)  (1280 + 64 * (j))
#define XB_XGEN(j)  (2304 + 64 * (j))
#define XB_TOP      3328
#define XB_TOPGEN   3392
#define XCD_BAR_WORDS 3456
#define XB_SPIN_CAP (1u << 18)
#define LAS __attribute__((address_space(3)))

__device__ __forceinline__ unsigned xb_ld(unsigned* p)              { return __hip_atomic_load(p, __ATOMIC_RELAXED, __HIP_MEMORY_SCOPE_AGENT); }
__device__ __forceinline__ unsigned xb_add(unsigned* p, unsigned v) { return __hip_atomic_fetch_add(p, v, __ATOMIC_RELAXED, __HIP_MEMORY_SCOPE_AGENT); }
__device__ __forceinline__ unsigned xb_xcc_id() { return (unsigned)__builtin_amdgcn_s_getreg((3 << 11) | 20) & 0xFu; }
#define XB_SPIN(cond, bar) do { unsigned _sp = 0; while (cond) { __builtin_amdgcn_s_sleep(1); \
    if ((++_sp & 255u) == 0u) { if (xb_ld(&(bar)[XB_TMO])) break; if (_sp > XB_SPIN_CAP) { atomicAdd(&(bar)[XB_TMO], 1u); break; } } } } while (0)

struct XcdBarrier {
    unsigned* bar; unsigned x;
    volatile LAS unsigned* st;
};

__device__ __forceinline__ XcdBarrier xcd_barrier_post(unsigned* bar, volatile LAS unsigned* st) {
    XcdBarrier b; b.bar = bar; b.x = xb_xcc_id(); b.st = st;
    if (threadIdx.x == 0) (void)xb_add(&bar[XB_XCNT(b.x)], 1u);
    return b;
}
__device__ __forceinline__ void xcd_barrier_complete(unsigned* bar, unsigned x, unsigned& nloc, unsigned& nx) {
    const unsigned G = gridDim.x * gridDim.y * gridDim.z;
    unsigned sum, cnt, mine, sp = 0u;
    for (;;) {
        sum = 0u; cnt = 0u; mine = 0u;
#pragma unroll
        for (unsigned j = 0; j < 16; ++j) { const unsigned c = xb_ld(&bar[XB_XCNT(j)]); sum += c; cnt += (c > 0u) ? 1u : 0u; mine = (j == x) ? c : mine; }
        if (sum == G) break;
        __builtin_amdgcn_s_sleep(1);
        if ((++sp & 255u) == 0u) { if (xb_ld(&bar[XB_TMO])) break; if (sp > XB_SPIN_CAP) { atomicAdd(&bar[XB_TMO], 1u); break; } }
    }
    nloc = mine > 0u ? mine : 1u; nx = cnt > 0u ? cnt : 1u;
}

__device__ __forceinline__ void xcd_barrier(const XcdBarrier& b) {
    asm volatile("s_waitcnt vmcnt(0)" ::: "memory");
    __syncthreads();
    if (threadIdx.x == 0) {
        unsigned* bar = b.bar;
        __builtin_amdgcn_s_waitcnt(0);
        unsigned nloc = b.st[0], nx = b.st[1];
        if (nloc == 0u) { xcd_barrier_complete(bar, b.x, nloc, nx); b.st[0] = nloc; b.st[1] = nx; }
        const unsigned old = xb_add(&bar[XB_XSUB(b.x)], 1u);
        const unsigned gen = old / nloc;
        if (old + 1u == (gen + 1u) * nloc) {
            __builtin_amdgcn_fence(__ATOMIC_RELEASE, "agent");
            asm volatile("s_waitcnt vmcnt(0)" ::: "memory");
            const unsigned og = xb_add(&bar[XB_TOP], 1u);
            const unsigned tg = og / nx;
            if (og + 1u == (tg + 1u) * nx) xb_add(&bar[XB_TOPGEN], 1u);
            else XB_SPIN(xb_ld(&bar[XB_TOPGEN]) == tg, bar);
            __builtin_amdgcn_fence(__ATOMIC_ACQUIRE, "agent");
            xb_add(&bar[XB_XGEN(b.x)], 1u);
            asm volatile("s_waitcnt vmcnt(0)" ::: "memory");
        } else {
            XB_SPIN(xb_ld(&bar[XB_XGEN(b.x)]) == gen, bar);
            __builtin_amdgcn_fence(__ATOMIC_ACQUIRE, "agent");
            asm volatile("s_waitcnt vmcnt(0)" ::: "memory");
        }
    }
    __syncthreads();
}

constexpr int T = 16384, D = 2048, NTHR = 512, NWAVES = 8;
constexpr int NU = 5632;
constexpr int N_IN = 5648, N_IN_PAD = 5888;
constexpr int NCHUNK = 256;
constexpr int NE = 32, FF = 1024;
constexpr int MAX_TILES = 160;
constexpr float EPS = 1e-6f;
enum { IN_X = 0, IN_C, IN_WADA, IN_BADA, IN_N1W, IN_WIN, IN_CONVW, IN_SCONVW, IN_SCONVB, IN_DTB, IN_ALOG, IN_DSKIP, IN_SNW, IN_WOUT, IN_N2W, IN_WRG, IN_BRG, IN_WRE, IN_BRE, IN_WG, IN_WU, IN_WD, IN_FNW, N_INPUTS };

constexpr size_t KiB = 1024, MiB = 1u << 20;
constexpr size_t WS_CTL = 0, CTL_ZERO_BYTES = 1 * MiB;
constexpr size_t WS_MOD = 1 * MiB;
constexpr size_t WS_BIAS2 = 1 * MiB + 56 * KiB;
constexpr size_t WS_W2T = 1 * MiB + 64 * KiB;
constexpr size_t WS_BLKCNT = 1536 * KiB;
constexpr size_t WS_TILE = 1600 * KiB;
constexpr size_t WS_SLOT = 1664 * KiB;
constexpr size_t WS_EW = 1792 * KiB;
constexpr size_t WS_EID = 1920 * KiB;
constexpr size_t WS_RANK = 5 * MiB;
constexpr size_t WS_DT = 2 * MiB, WS_ACS = 3 * MiB, WS_UDT = 4 * MiB;
constexpr size_t WS_WIN = 8 * MiB;
constexpr size_t WS_WOUT = 32 * MiB;
constexpr size_t WS_WGU = 40 * MiB;
constexpr size_t WS_WD = 296 * MiB;
constexpr size_t WS_H = 424 * MiB;
constexpr size_t WS_U = 488 * MiB;
constexpr size_t WS_YMIX = 664 * MiB;
constexpr size_t WS_XS = 744 * MiB;
constexpr size_t WS_BM = 776 * MiB, WS_CM = 784 * MiB;
constexpr size_t WS_ST = 792 * MiB;
constexpr size_t WS_BMT = 856 * MiB;
constexpr size_t WS_YB = 744 * MiB;
constexpr size_t WS_END = 904 * MiB;
constexpr int CW_DBG = 16;
constexpr int CW_BAR = 4096;

constexpr int RING_BYTES = 131072;
constexpr int MISC_OFF = 131072;
constexpr int LDS_BYTES = 131072 + 1024;

#define GAS __attribute__((address_space(1)))
typedef unsigned short bf16;
typedef unsigned v4u __attribute__((ext_vector_type(4)));
typedef unsigned v2u __attribute__((ext_vector_type(2)));
typedef float f32x4 __attribute__((ext_vector_type(4)));
#define LDS_WAIT() asm volatile("s_waitcnt lgkmcnt(0)" ::: "memory")
__device__ __forceinline__ float bflo(unsigned u) { return __builtin_bit_cast(float, u << 16); }
__device__ __forceinline__ float bfhi(unsigned u) { return __builtin_bit_cast(float, u & 0xffff0000u); }
__device__ __forceinline__ unsigned pk2(float lo, float hi) { return pg8::cvt_pk_bf16(lo, hi); }
__device__ __forceinline__ float wave_sum(float v) {
#pragma unroll
    for (int o = 1; o < 64; o <<= 1) v += __shfl_xor(v, o);
    return v;
}
__device__ __forceinline__ float silu_f(float v) { return v / (1.f + __expf(-v)); }

struct Args { const float* in[N_INPUTS]; float* out; unsigned char* ws; int ph_lo, ph_hi, li, pad; };

struct Frame {
    LAS unsigned char* lds;
    int tid, lane, wave, G, vcu, bid;
    unsigned char* ws;
};

struct ConvJob { const float* wg; const float* wu; const float* wd; bf16* dgu; bf16* dd; };
__device__ __forceinline__ void k8_item_addr(const ConvJob& J, int id, int lane, const float*& src, int& ldw, bf16*& dst) {
    if (id < 65536) { const int up = id >> 15, r0 = id & 32767, e = r0 >> 10, r = r0 & 1023, kb = r >> 2, nb = r & 3, n = nb * 256 + 4 * lane;
        src = (up ? J.wu : J.wg) + (size_t)e * D * FF + (size_t)(kb * 8) * FF + n; ldw = FF;
        const int drow = ((n >> 7) << 8) + (up ? 128 : 0) + (n & 127);
        dst = J.dgu + (size_t)e * 2048 * D + ((size_t)kb * 2048 + drow) * 8; }
    else { const int r0 = id - 65536, e = r0 >> 10, r = r0 & 1023, kb = r >> 3, nb = r & 7, n = nb * 256 + 4 * lane;
        src = J.wd + (size_t)e * FF * D + (size_t)(kb * 8) * D + n; ldw = D;
        dst = J.dd + (size_t)e * 2048 * FF + ((size_t)kb * 2048 + n) * 8; }
}
__device__ __forceinline__ void k8_convert(const ConvJob& J, int it0, int nit, int lane) {
#pragma unroll 1
    for (int it = it0; it < it0 + nit; it += 2) {
        const float* s0; const float* s1; int l0, l1; bf16* d0; bf16* d1;
        k8_item_addr(J, it, lane, s0, l0, d0); k8_item_addr(J, it + 1, lane, s1, l1, d1);
        f32x4 v0[8], v1[8];
#pragma unroll
        for (int i = 0; i < 8; ++i) { v0[i] = __builtin_nontemporal_load((const f32x4*)(s0 + (size_t)i * l0)); v1[i] = __builtin_nontemporal_load((const f32x4*)(s1 + (size_t)i * l1)); }
#pragma unroll
        for (int j = 0; j < 4; ++j) { v4u o; o.x = pk2(v0[0][j], v0[1][j]); o.y = pk2(v0[2][j], v0[3][j]); o.z = pk2(v0[4][j], v0[5][j]); o.w = pk2(v0[6][j], v0[7][j]); __builtin_nontemporal_store(o, (v4u*)(d0 + j * 8)); }
#pragma unroll
        for (int j = 0; j < 4; ++j) { v4u o; o.x = pk2(v1[0][j], v1[1][j]); o.y = pk2(v1[2][j], v1[3][j]); o.z = pk2(v1[4][j], v1[5][j]); o.w = pk2(v1[6][j], v1[7][j]); __builtin_nontemporal_store(o, (v4u*)(d1 + j * 8)); }
    }
}
struct ConvOrder : pg8::StaticOrder {
    ConvJob J; int pos, it0, nit;
    __device__ __forceinline__ void done(const pg8::Unit&, int ui) const { if (ui == pos) k8_convert(J, it0, nit, (int)(threadIdx.x & 63)); }
};

__device__ __forceinline__ void p0_ada(const Frame& F, const float* cvec, const float* w_ada, const float* b_ada, float* mod) {
    LAS float* red = (LAS float*)F.lds;
    const int kq = F.tid / 12, cq = F.tid % 12;
    for (int chunk = F.vcu; chunk < 256; chunk += F.G) {
        if (F.tid < 504) {
            f32x4 acc = (f32x4){0.f, 0.f, 0.f, 0.f};
            const float* wp = w_ada + 48 * chunk + 4 * cq;
#pragma unroll 7
            for (int i = 0; i < 49; ++i) {
                const int k = kq + 42 * i; const bool ok = k < D; const int kk = ok ? k : 0;
                const float cv = cvec[kk]; const float s = ok ? cv / (1.f + expf(-cv)) : 0.f;
                const f32x4 w = *(const f32x4*)(wp + (size_t)kk * 12288);
                acc += s * w;
            }
            *(LAS f32x4*)(red + kq * 48 + 4 * cq) = acc;
        }
        __syncthreads();
        if (F.tid < 48) { float s = 0.f; for (int q = 0; q < 42; ++q) s += red[q * 48 + F.tid]; mod[48 * chunk + F.tid] = s + b_ada[48 * chunk + F.tid]; }
        __syncthreads();
    }
}
__device__ __forceinline__ void tr_item(const float* W, int ldw, int nvalid, int k0, int n0, bf16* dst, int ldd, LAS float* scr, int lane) {
    const int nn = n0 + (lane & 31); const bool ok = nn < nvalid; const int nc = ok ? nn : 0;
#pragma unroll 8
    for (int i = 0; i < 32; ++i) { const int kk = 2 * i + (lane >> 5); const float v = W[(size_t)(k0 + kk) * ldw + nc]; scr[kk * 33 + (lane & 31)] = ok ? v : 0.f; }
    LDS_WAIT();
    const int c = lane & 7;
#pragma unroll
    for (int j = 0; j < 4; ++j) { const int n = (lane >> 3) + 8 * j; const LAS float* s = scr + (8 * c) * 33 + n;
        v4u o; o.x = pk2(s[0 * 33], s[1 * 33]); o.y = pk2(s[2 * 33], s[3 * 33]); o.z = pk2(s[4 * 33], s[5 * 33]); o.w = pk2(s[6 * 33], s[7 * 33]);
        *(v4u*)(dst + (size_t)n * ldd + k0 + 8 * c) = o; }
    LDS_WAIT();
}
__device__ __forceinline__ void p0_convert(const Frame& F, const Args& a) {
    LAS float* scr = (LAS float*)(F.lds + 16384 + F.wave * 8704);
    bf16* Wt_in = (bf16*)(F.ws + WS_WIN); bf16* Wt_out = (bf16*)(F.ws + WS_WOUT);
    constexpr int I_IN = 32 * 177, I_OUT = 32 * 64, NITEMS = I_IN + I_OUT;
    const int gw = F.bid * NWAVES + F.wave, NGW = F.G * NWAVES;
    for (int it = gw; it < NITEMS; it += NGW) {
        int r = it;
        if (r < I_IN) { const int kb = r / 177, nb = r % 177; tr_item(a.in[IN_WIN], N_IN, N_IN, 64 * kb, 32 * nb, Wt_in + (size_t)(32 * nb) * D, D, scr, F.lane); continue; } r -= I_IN;
        { const int kb = r / 64, nb = r % 64; tr_item(a.in[IN_WOUT], D, D, 64 * kb, 32 * nb, Wt_out + (size_t)(32 * nb) * D, D, scr, F.lane); }
    }
    v4u* z = (v4u*)(Wt_in + (size_t)5664 * D); const int nz = 224 * D * 2 / 16;
    for (int i = F.bid * NTHR + F.tid; i < nz; i += F.G * NTHR) z[i] = (v4u){0u, 0u, 0u, 0u};
}

__device__ __forceinline__ void norm_rows(const Frame& F, const float* X, const float* nw, const float* sc, const float* sh, bf16* H) {
    f32x4 av[8], sv[8];
#pragma unroll
    for (int j = 0; j < 8; ++j) { const int k = 4 * F.lane + 256 * j; const f32x4 w = *(const f32x4*)(nw + k), s = *(const f32x4*)(sc + k); av[j] = w * (s + 1.f); sv[j] = *(const f32x4*)(sh + k); }
    const int gw = F.bid * NWAVES + F.wave, NGW = F.G * NWAVES;
    f32x4 nx[8];
    if (gw < T) {
#pragma unroll
        for (int j = 0; j < 8; ++j) nx[j] = ((const f32x4*)(X + (size_t)gw * D) + F.lane)[64 * j]; }
    for (int row = gw; row < T; row += NGW) {
        f32x4 v[8]; float s = 0.f;
#pragma unroll
        for (int j = 0; j < 8; ++j) { v[j] = nx[j]; s += (v[j].x * v[j].x + v[j].y * v[j].y) + (v[j].z * v[j].z + v[j].w * v[j].w); }
        if (row + NGW < T) {
#pragma unroll
            for (int j = 0; j < 8; ++j) nx[j] = ((const f32x4*)(X + (size_t)(row + NGW) * D) + F.lane)[64 * j]; }
        const float rstd = 1.f / sqrtf(wave_sum(s) * (1.f / D) + EPS);
        v2u* o = (v2u*)(H + (size_t)row * D) + F.lane;
#pragma unroll
        for (int j = 0; j < 8; ++j) { const f32x4 h = v[j] * rstd * av[j] + sv[j]; v2u w; w.x = pk2(h.x, h.y); w.y = pk2(h.z, h.w); o[64 * j] = w; }
    }
}
__device__ __forceinline__ void p1_router_prep(const Frame& F, const Args& a) {
    const float* mod = (const float*)(F.ws + WS_MOD); const float* sh2 = mod + 3 * D; const float* sc2 = mod + 4 * D;
    float* w2t = (float*)(F.ws + WS_W2T); float* bias2 = (float*)(F.ws + WS_BIAS2);
    const float* wrg = a.in[IN_WRG]; const float* wre = a.in[IN_WRE]; const float* n2w = a.in[IN_N2W];
    for (int i = F.bid * NTHR + F.tid; i < 48 * D; i += F.G * NTHR) {
        const int c = i / D, k = i % D; float v = 0.f;
        if (c < 36) { const float w = c < 4 ? wrg[k * 4 + c] : wre[k * 32 + (c - 4)]; v = w * n2w[k] * (1.f + sc2[k]); }
        w2t[i] = v;
    }
    if (F.bid == 0) {
        for (int c = F.wave; c < 48; c += NWAVES) { float s = 0.f;
            if (c < 36) { for (int k = F.lane; k < D; k += 64) { const float w = c < 4 ? wrg[k * 4 + c] : wre[k * 32 + (c - 4)]; s += sh2[k] * w; } s = wave_sum(s); s += c < 4 ? a.in[IN_BRG][c] : a.in[IN_BRE][c - 4]; }
            if (F.lane == 0) bias2[c] = s; }
    }
}

typedef short bf16x8 __attribute__((ext_vector_type(8)));
__device__ __forceinline__ f32x4 mma16(bf16x8 a, bf16x8 b, f32x4 c) { return __builtin_amdgcn_mfma_f32_16x16x32_bf16(a, b, c, 0, 0, 0); }

template <int MODE>
__device__ __forceinline__ void conv4_pair(const Frame& F, const Args& a, int c, int pp) {
    const int t0 = c * 64;
    const bf16* U = (const bf16*)(F.ws + WS_U);
    const float* cw = a.in[IN_SCONVW]; const float* cb = a.in[IN_SCONVB];
    float wa[4], wb[4];
#pragma unroll
    for (int j = 0; j < 4; ++j) { wa[j] = cw[j * 1536 + 2 * pp]; wb[j] = cw[j * 1536 + 2 * pp + 1]; }
    const float bia = cb[2 * pp], bib = cb[2 * pp + 1];
    float p3a = 0.f, p3b = 0.f, p2a = 0.f, p2b = 0.f, p1a = 0.f, p1b = 0.f;
    if (c > 0) {
        const unsigned u3 = ((const unsigned*)(U + (size_t)(t0 - 3) * NU + 4096))[pp], u2 = ((const unsigned*)(U + (size_t)(t0 - 2) * NU + 4096))[pp], u1 = ((const unsigned*)(U + (size_t)(t0 - 1) * NU + 4096))[pp];
        p3a = bflo(u3); p3b = bfhi(u3); p2a = bflo(u2); p2b = bfhi(u2); p1a = bflo(u1); p1b = bfhi(u1);
    }
    bf16* xsT = (bf16*)(F.ws + WS_XS); bf16* Bm = (bf16*)(F.ws + WS_BM); bf16* Cm = (bf16*)(F.ws + WS_CM); bf16* BmT = (bf16*)(F.ws + WS_BMT);
    unsigned un[8];
#pragma unroll
    for (int i = 0; i < 8; ++i) un[i] = ((const unsigned*)(U + (size_t)(t0 + i) * NU + 4096))[pp];
#pragma unroll
    for (int tb = 0; tb < 8; ++tb) {
        unsigned uu[8];
#pragma unroll
        for (int i = 0; i < 8; ++i) uu[i] = un[i];
        if (tb < 7) {
#pragma unroll
            for (int i = 0; i < 8; ++i) un[i] = ((const unsigned*)(U + (size_t)(t0 + (tb + 1) * 8 + i) * NU + 4096))[pp]; }
        float ya[8], yb[8];
#pragma unroll
        for (int i = 0; i < 8; ++i) { const float ua = bflo(uu[i]), ub = bfhi(uu[i]);
            ya[i] = silu_f(wa[0] * p3a + wa[1] * p2a + wa[2] * p1a + wa[3] * ua + bia); yb[i] = silu_f(wb[0] * p3b + wb[1] * p2b + wb[2] * p1b + wb[3] * ub + bib);
            p3a = p2a; p3b = p2b; p2a = p1a; p2b = p1b; p1a = ua; p1b = ub; }
        if (MODE != 2) { v4u va, vb;
#pragma unroll
            for (int q = 0; q < 4; ++q) { va[q] = pk2(ya[2 * q], ya[2 * q + 1]); vb[q] = pk2(yb[2 * q], yb[2 * q + 1]); }
            if (MODE == 0) { bf16* o = xsT + ((size_t)c * 1024 + 2 * pp) * 64 + tb * 8; *(v4u*)o = va; *(v4u*)(o + 64) = vb; }
            else { bf16* o = BmT + ((size_t)c * 256 + 2 * (pp - 512)) * 64 + tb * 8; *(v4u*)o = va; *(v4u*)(o + 64) = vb; } }
        if (MODE == 1) {
#pragma unroll
            for (int i = 0; i < 8; ++i) ((unsigned*)(Bm + (size_t)(t0 + tb * 8 + i) * 256))[pp - 512] = pk2(ya[i], yb[i]); }
        if (MODE == 2) {
#pragma unroll
            for (int i = 0; i < 8; ++i) ((unsigned*)(Cm + (size_t)(t0 + tb * 8 + i) * 256))[pp - 640] = pk2(ya[i], yb[i]); }
    }
}

__device__ __forceinline__ void p3_chunk(const Frame& F, const Args& a, int c) {
    const int t0 = c * 64, tid = F.tid;
    const bf16* U = (const bf16*)(F.ws + WS_U); bf16* ymix = (bf16*)(F.ws + WS_YMIX);
    {
        const float* cw = a.in[IN_CONVW];
        const float w0a = cw[2 * tid], w0b = cw[2 * tid + 1], w1a = cw[1024 + 2 * tid], w1b = cw[1024 + 2 * tid + 1], w2a = cw[2048 + 2 * tid], w2b = cw[2048 + 2 * tid + 1];
        float p2a = 0.f, p2b = 0.f, p1a = 0.f, p1b = 0.f;
        if (c > 0) { const unsigned* u2 = (const unsigned*)(U + (size_t)(t0 - 2) * NU); const unsigned* u1 = (const unsigned*)(U + (size_t)(t0 - 1) * NU);
            const unsigned c2 = u2[512 + tid], v2 = u2[1024 + tid], c1 = u1[512 + tid], v1 = u1[1024 + tid];
            p2a = bflo(c2) * bflo(v2); p2b = bfhi(c2) * bfhi(v2); p1a = bflo(c1) * bflo(v1); p1b = bfhi(c1) * bfhi(v1); }
        unsigned nb_[8], nc_[8], nv_[8];
#pragma unroll
        for (int i = 0; i < 8; ++i) { const unsigned* ur = (const unsigned*)(U + (size_t)(t0 + i) * NU); nb_[i] = ur[tid]; nc_[i] = ur[512 + tid]; nv_[i] = ur[1024 + tid]; }
#pragma unroll
        for (int tb = 0; tb < 8; ++tb) {
            unsigned cb_[8], cc_[8], cv_[8];
#pragma unroll
            for (int i = 0; i < 8; ++i) { cb_[i] = nb_[i]; cc_[i] = nc_[i]; cv_[i] = nv_[i]; }
            if (tb < 7) {
#pragma unroll
                for (int i = 0; i < 8; ++i) { const unsigned* ur = (const unsigned*)(U + (size_t)(t0 + (tb + 1) * 8 + i) * NU); nb_[i] = ur[tid]; nc_[i] = ur[512 + tid]; nv_[i] = ur[1024 + tid]; } }
#pragma unroll
            for (int i = 0; i < 8; ++i) {
                const float cva = bflo(cc_[i]) * bflo(cv_[i]), cvb = bfhi(cc_[i]) * bfhi(cv_[i]);
                const float ya = bflo(cb_[i]) * (w0a * p2a + w1a * p1a + w2a * cva), yb = bfhi(cb_[i]) * (w0b * p2b + w1b * p1b + w2b * cvb);
                ((unsigned*)(ymix + (size_t)(t0 + tb * 8 + i) * D))[tid] = pk2(ya, yb);
                p2a = p1a; p2b = p1b; p1a = cva; p1b = cvb;
            }
        }
    }
    conv4_pair<0>(F, a, c, tid);
    if (tid < 128) conv4_pair<1>(F, a, c, tid + 512); else if (tid < 256) conv4_pair<2>(F, a, c, tid + 512);
    float* dtT = (float*)(F.ws + WS_DT); float* acsT = (float*)(F.ws + WS_ACS); const float* udt = (const float*)(F.ws + WS_UDT);
#pragma unroll
    for (int hi = 0; hi < 2; ++hi) {
        const int h = F.wave + 8 * hi; const float bias = a.in[IN_DTB][h], A = -expf(a.in[IN_ALOG][h]);
        const float x = udt[(size_t)(t0 + F.lane) * 16 + h] + bias; const float dt = fmaxf(x, 0.f) + log1pf(expf(-fabsf(x)));
        float cs = A * dt;
#pragma unroll
        for (int o = 1; o < 64; o <<= 1) { const float v = __shfl_up(cs, o); cs += (F.lane >= o) ? v : 0.f; }
        dtT[((size_t)c * 16 + h) * 64 + F.lane] = dt; acsT[((size_t)c * 16 + h) * 64 + F.lane] = cs;
    }
    asm volatile("s_waitcnt vmcnt(0)" ::: "memory");
    __syncthreads();
    const bf16* xsT = (const bf16*)(F.ws + WS_XS); const bf16* BmT = (const bf16*)(F.ws + WS_BMT); bf16* st = (bf16*)(F.ws + WS_ST);
    const int fr = F.lane & 15, fq = F.lane >> 4;
#pragma unroll 1
    for (int hi = 0; hi < 2; ++hi) {
        const int h = F.wave + 8 * hi, g = h >> 3;
        const float* dT = dtT + ((size_t)c * 16 + h) * 64; const float* aT = acsT + ((size_t)c * 16 + h) * 64; const float a63 = aT[63];
        bf16x8 xb[4][2];
#pragma unroll
        for (int ks = 0; ks < 2; ++ks) {
            const f32x4 d0 = *(const f32x4*)(dT + 32 * ks + 8 * fq), d1 = *(const f32x4*)(dT + 32 * ks + 8 * fq + 4), a0 = *(const f32x4*)(aT + 32 * ks + 8 * fq), a1 = *(const f32x4*)(aT + 32 * ks + 8 * fq + 4);
            float w[8];
#pragma unroll
            for (int j = 0; j < 4; ++j) { w[j] = d0[j] * __expf(a63 - a0[j]); w[4 + j] = d1[j] * __expf(a63 - a1[j]); }
#pragma unroll
            for (int nb = 0; nb < 4; ++nb) { const v4u raw = *(const v4u*)(xsT + ((size_t)c * 1024 + h * 64 + nb * 16 + fr) * 64 + 32 * ks + 8 * fq); v4u sc;
#pragma unroll
                for (int q = 0; q < 4; ++q) sc[q] = pk2(bflo(raw[q]) * w[2 * q], bfhi(raw[q]) * w[2 * q + 1]);
                xb[nb][ks] = __builtin_bit_cast(bf16x8, sc); }
        }
#pragma unroll 1
        for (int half = 0; half < 2; ++half) {
            f32x4 acc[4][4];
#pragma unroll
            for (int mb = 0; mb < 4; ++mb)
#pragma unroll
                for (int nb = 0; nb < 4; ++nb) acc[mb][nb] = (f32x4){0.f, 0.f, 0.f, 0.f};
#pragma unroll
            for (int ks = 0; ks < 2; ++ks)
#pragma unroll
                for (int mb = 0; mb < 4; ++mb) { const bf16x8 av = *(const bf16x8*)(BmT + ((size_t)c * 256 + g * 128 + half * 64 + mb * 16 + fr) * 64 + 32 * ks + 8 * fq);
#pragma unroll
                    for (int nb = 0; nb < 4; ++nb) acc[mb][nb] = mma16(av, xb[nb][ks], acc[mb][nb]); }
#pragma unroll
            for (int mb = 0; mb < 4; ++mb)
#pragma unroll
                for (int nb = 0; nb < 4; ++nb) { v2u w; w.x = pk2(acc[mb][nb][0], acc[mb][nb][1]); w.y = pk2(acc[mb][nb][2], acc[mb][nb][3]);
                    *(v2u*)(st + (((size_t)c * 16 + h) * 64 + nb * 16 + fr) * 128 + half * 64 + mb * 16 + 4 * fq) = w; }
        }
    }
}

__device__ __forceinline__ void p_scan(const Frame& F) {
    bf16* st = (bf16*)(F.ws + WS_ST); const float* acsT = (const float*)(F.ws + WS_ACS);
    for (int e = F.bid * NTHR + F.tid; e < 16 * 64 * 128; e += F.G * NTHR) {
        const int head = e >> 13; float h = 0.f;
#pragma unroll 1
        for (int cb = 0; cb < NCHUNK; cb += 32) {
            unsigned short sv[32]; float dv[32];
#pragma unroll
            for (int i = 0; i < 32; ++i) { sv[i] = st[(size_t)(cb + i) * 131072 + e]; dv[i] = acsT[((size_t)(cb + i) * 16 + head) * 64 + 63]; }
#pragma unroll
            for (int i = 0; i < 32; ++i) { st[(size_t)(cb + i) * 131072 + e] = (bf16)(pk2(h, 0.f) & 0xffffu); h = h * __expf(dv[i]) + bflo((unsigned)sv[i]); }
        }
    }
}

__device__ __forceinline__ void p4_unit(const Frame& F, const Args& a, int c, int g) {
    const int t0 = c * 64, hh = F.wave, h = g * 8 + hh, fr = F.lane & 15, fq = F.lane >> 4;
    const bf16* U = (const bf16*)(F.ws + WS_U); bf16* ymix = (bf16*)(F.ws + WS_YMIX);
    const bf16* xsT = (const bf16*)(F.ws + WS_XS); const bf16* Bm = (const bf16*)(F.ws + WS_BM); const bf16* Cm = (const bf16*)(F.ws + WS_CM);
    const float* dT = (const float*)(F.ws + WS_DT) + ((size_t)c * 16 + h) * 64; const float* aT = (const float*)(F.ws + WS_ACS) + ((size_t)c * 16 + h) * 64;
    const bf16* pv = (const bf16*)(F.ws + WS_ST) + ((size_t)c * 16 + h) * 64 * 128;
    LAS unsigned char* mbuf = F.lds + hh * 9216;
    LAS float* sred = (LAS float*)(F.lds + 73728);
    LAS float* srs = (LAS float*)(F.lds + 75776);
    float al[4];
#pragma unroll
    for (int nb = 0; nb < 4; ++nb) al[nb] = aT[nb * 16 + fr];
    bf16x8 cf[4][4];
#pragma unroll
    for (int nb = 0; nb < 4; ++nb)
#pragma unroll
        for (int ks = 0; ks < 4; ++ks) cf[nb][ks] = *(const bf16x8*)(Cm + (size_t)(t0 + nb * 16 + fr) * 256 + g * 128 + 32 * ks + 8 * fq);
    f32x4 acc[4][4];
#pragma unroll
    for (int mb = 0; mb < 4; ++mb)
#pragma unroll
        for (int nb = 0; nb < 4; ++nb) acc[mb][nb] = (f32x4){0.f, 0.f, 0.f, 0.f};
#pragma unroll
    for (int ks = 0; ks < 4; ++ks)
#pragma unroll
        for (int mb = 0; mb < 4; ++mb) { const bf16x8 bv = *(const bf16x8*)(Bm + (size_t)(t0 + mb * 16 + fr) * 256 + g * 128 + 32 * ks + 8 * fq);
#pragma unroll
            for (int nb = 0; nb < 4; ++nb) acc[mb][nb] = mma16(bv, cf[nb][ks], acc[mb][nb]); }
    {
        const float dsk = a.in[IN_DSKIP][h];
#pragma unroll
        for (int mb = 0; mb < 4; ++mb) { const f32x4 as = *(const f32x4*)(aT + mb * 16 + 4 * fq), ds = *(const f32x4*)(dT + mb * 16 + 4 * fq);
#pragma unroll
            for (int nb = 0; nb < 4; ++nb) { const int l = nb * 16 + fr; float m[4];
#pragma unroll
                for (int r = 0; r < 4; ++r) { const int s = mb * 16 + 4 * fq + r; const float v = acc[mb][nb][r] * __expf(al[nb] - as[r]) * ds[r]; m[r] = (s <= l) ? v : 0.f; m[r] += (s == l) ? dsk : 0.f; }
                v2u w; w.x = pk2(m[0], m[1]); w.y = pk2(m[2], m[3]);
                *(LAS v2u*)(mbuf + l * 144 + (mb * 16 + 4 * fq) * 2) = w; } }
    }
#pragma unroll
    for (int mb = 0; mb < 4; ++mb)
#pragma unroll
        for (int nb = 0; nb < 4; ++nb) acc[mb][nb] = (f32x4){0.f, 0.f, 0.f, 0.f};
#pragma unroll
    for (int ks = 0; ks < 4; ++ks)
#pragma unroll
        for (int mb = 0; mb < 4; ++mb) { const bf16x8 pvv = *(const bf16x8*)(pv + (size_t)(mb * 16 + fr) * 128 + 32 * ks + 8 * fq);
#pragma unroll
            for (int nb = 0; nb < 4; ++nb) acc[mb][nb] = mma16(pvv, cf[nb][ks], acc[mb][nb]); }
#pragma unroll
    for (int nb = 0; nb < 4; ++nb) { const float ea = __expf(al[nb]);
#pragma unroll
        for (int mb = 0; mb < 4; ++mb) acc[mb][nb] = acc[mb][nb] * ea; }
    LDS_WAIT();
#pragma unroll
    for (int ks = 0; ks < 2; ++ks) {
        bf16x8 mf[4];
#pragma unroll
        for (int nb = 0; nb < 4; ++nb) mf[nb] = *(const LAS bf16x8*)(mbuf + (nb * 16 + fr) * 144 + (32 * ks + 8 * fq) * 2);
#pragma unroll
        for (int mb = 0; mb < 4; ++mb) { const bf16x8 xv = *(const bf16x8*)(xsT + ((size_t)c * 1024 + h * 64 + mb * 16 + fr) * 64 + 32 * ks + 8 * fq);
#pragma unroll
            for (int nb = 0; nb < 4; ++nb) acc[mb][nb] = mma16(xv, mf[nb], acc[mb][nb]); }
    }
    float ss[4] = {0.f, 0.f, 0.f, 0.f};
#pragma unroll
    for (int nb = 0; nb < 4; ++nb)
#pragma unroll
        for (int mb = 0; mb < 4; ++mb) { const v2u zv = *(const v2u*)(U + (size_t)(t0 + nb * 16 + fr) * NU + 3072 + h * 64 + mb * 16 + 4 * fq);
            f32x4 y = acc[mb][nb]; y[0] *= silu_f(bflo(zv.x)); y[1] *= silu_f(bfhi(zv.x)); y[2] *= silu_f(bflo(zv.y)); y[3] *= silu_f(bfhi(zv.y));
            acc[mb][nb] = y; ss[nb] += (y[0] * y[0] + y[1] * y[1]) + (y[2] * y[2] + y[3] * y[3]); }
#pragma unroll
    for (int nb = 0; nb < 4; ++nb) { float s = ss[nb]; s += __shfl_xor(s, 16); s += __shfl_xor(s, 32); if (fq == 0) sred[hh * 64 + nb * 16 + fr] = s; }
    __syncthreads();
    if (F.tid < 64) { float s = 0.f;
#pragma unroll
        for (int w = 0; w < 8; ++w) s += sred[w * 64 + F.tid];
        srs[F.tid] = 1.f / sqrtf(s * (1.f / 512.f) + EPS); }
    __syncthreads();
    {
        const float* nw = a.in[IN_SNW] + h * 64;
#pragma unroll
        for (int nb = 0; nb < 4; ++nb) { const float r = srs[nb * 16 + fr];
#pragma unroll
            for (int mb = 0; mb < 4; ++mb) { const f32x4 n4 = *(const f32x4*)(nw + mb * 16 + 4 * fq); const f32x4 y = acc[mb][nb] * r * n4;
                v2u w; w.x = pk2(y[0], y[1]); w.y = pk2(y[2], y[3]);
                *(v2u*)(ymix + (size_t)(t0 + nb * 16 + fr) * D + 1024 + h * 64 + mb * 16 + 4 * fq) = w; } }
    }
    __syncthreads();
}

__device__ __forceinline__ void p6_unit(const Frame& F, const Args& a, int u) {
    const int t0 = u * 64, tid = F.tid, lane = F.lane, wave = F.wave;
    const float* X1 = a.out; const float* w2t = (const float*)(F.ws + WS_W2T); const float* bias2 = (const float*)(F.ws + WS_BIAS2);
    const float* mod = (const float*)(F.ws + WS_MOD);
    LAS float* spart = (LAS float*)F.lds;
    LAS float* sssq = (LAS float*)(F.lds + 98304);
    LAS float* srstd = (LAS float*)(F.lds + 100352);
    LAS int* seid = (LAS int*)(F.lds + 100608);
    LAS int* shist = (LAS int*)(F.lds + 101120);
    const int r16 = lane & 15, q = lane >> 4, k0 = wave * 256 + 4 * q;
    f32x4 acc[4][3];
#pragma unroll
    for (int rb = 0; rb < 4; ++rb)
#pragma unroll
        for (int cb = 0; cb < 3; ++cb) acc[rb][cb] = (f32x4){0.f, 0.f, 0.f, 0.f};
    float ssq[4] = {0.f, 0.f, 0.f, 0.f};
    const float* xrow = X1 + (size_t)(t0 + r16) * D + k0;
    const float* wrow = w2t + (size_t)r16 * D + k0;
#pragma unroll 2
    for (int s = 0; s < 16; ++s) {
        f32x4 av[4], bv[3];
#pragma unroll
        for (int rb = 0; rb < 4; ++rb) av[rb] = *(const f32x4*)(xrow + (size_t)rb * 16 * D + 16 * s);
#pragma unroll
        for (int cb = 0; cb < 3; ++cb) bv[cb] = *(const f32x4*)(wrow + (size_t)cb * 16 * D + 16 * s);
#pragma unroll
        for (int rb = 0; rb < 4; ++rb) ssq[rb] += (av[rb].x * av[rb].x + av[rb].y * av[rb].y) + (av[rb].z * av[rb].z + av[rb].w * av[rb].w);
#pragma unroll
        for (int e = 0; e < 4; ++e)
#pragma unroll
            for (int rb = 0; rb < 4; ++rb)
#pragma unroll
                for (int cb = 0; cb < 3; ++cb) acc[rb][cb] = __builtin_amdgcn_mfma_f32_16x16x4f32(av[rb][e], bv[cb][e], acc[rb][cb], 0, 0, 0);
    }
#pragma unroll
    for (int rb = 0; rb < 4; ++rb)
#pragma unroll
        for (int cb = 0; cb < 3; ++cb)
#pragma unroll
            for (int r = 0; r < 4; ++r) spart[(wave * 64 + rb * 16 + 4 * q + r) * 48 + cb * 16 + r16] = acc[rb][cb][r];
#pragma unroll
    for (int rb = 0; rb < 4; ++rb) { float s = ssq[rb]; s += __shfl_xor(s, 16); s += __shfl_xor(s, 32); if (q == 0) sssq[wave * 64 + rb * 16 + r16] = s; }
    if (tid < 32) shist[tid] = 0;
    __syncthreads();
    LAS float* slog = (LAS float*)(F.lds + 102400);
    for (int i = tid; i < 64 * 48; i += NTHR) { float v = 0.f;
#pragma unroll
        for (int w = 0; w < 8; ++w) v += spart[w * 64 * 48 + i];
        slog[i] = v; }
    if (tid < 64) { float s = 0.f;
#pragma unroll
        for (int w = 0; w < 8; ++w) s += sssq[w * 64 + tid];
        srstd[tid] = 1.f / sqrtf(s * (1.f / D) + EPS); }
    __syncthreads();
    if (tid < 64) {
        const float rstd = srstd[tid];
        float lg[36];
#pragma unroll
        for (int c = 0; c < 36; ++c) lg[c] = slog[tid * 48 + c] * rstd + bias2[c];
        int gi = 0; float gm = lg[0];
#pragma unroll
        for (int c = 1; c < 4; ++c) if (lg[c] > gm) { gm = lg[c]; gi = c; }
        float gs = 0.f;
#pragma unroll
        for (int c = 0; c < 4; ++c) gs += expf(lg[c] - gm);
        const float grp_p = 1.f / gs;
        float le[8];
#pragma unroll
        for (int j = 0; j < 8; ++j) { float v = lg[4 + j];
#pragma unroll
            for (int g2 = 1; g2 < 4; ++g2) v = (gi == g2) ? lg[4 + g2 * 8 + j] : v;
            le[j] = v; }
        int j1 = 0; float m1 = le[0];
#pragma unroll
        for (int j = 1; j < 8; ++j) if (le[j] > m1) { m1 = le[j]; j1 = j; }
        int j2 = -1; float m2 = -3.0e38f;
#pragma unroll
        for (int j = 0; j < 8; ++j) if (j != j1 && le[j] > m2) { m2 = le[j]; j2 = j; }
        const float e2 = expf(m2 - m1), w1 = grp_p / (1.f + e2), w2 = grp_p * e2 / (1.f + e2);
        const int ex1 = gi * 8 + j1, ex2 = gi * 8 + j2, t = t0 + tid;
        ((int*)(F.ws + WS_EID))[2 * t] = ex1; ((int*)(F.ws + WS_EID))[2 * t + 1] = ex2;
        ((float*)(F.ws + WS_EW))[2 * t] = w1; ((float*)(F.ws + WS_EW))[2 * t + 1] = w2;
        seid[2 * tid] = ex1; seid[2 * tid + 1] = ex2;
        __hip_atomic_fetch_add(&shist[ex1], 1, __ATOMIC_RELAXED, __HIP_MEMORY_SCOPE_WORKGROUP); __hip_atomic_fetch_add(&shist[ex2], 1, __ATOMIC_RELAXED, __HIP_MEMORY_SCOPE_WORKGROUP);
    }
    __syncthreads();
    if (tid < 32) ((int*)(F.ws + WS_BLKCNT))[u * 32 + tid] = shist[tid];
    if (tid < 128) { const int e = seid[tid]; int r = 0; for (int j = 0; j < tid; ++j) r += (seid[j] == e) ? 1 : 0; ((int*)(F.ws + WS_RANK))[2 * t0 + tid] = r; }
    {
        const float* n2w = a.in[IN_N2W]; const float* sh2 = mod + 3 * D; const float* sc2 = mod + 4 * D; bf16* H = (bf16*)(F.ws + WS_H);
        f32x4 av2[8], bv2[8];
#pragma unroll
        for (int j = 0; j < 8; ++j) { const int k = 4 * lane + 256 * j; const f32x4 w = *(const f32x4*)(n2w + k), s = *(const f32x4*)(sc2 + k); av2[j] = w * (s + 1.f); bv2[j] = *(const f32x4*)(sh2 + k); }
#pragma unroll 1
        for (int i = 0; i < 8; i += 2) {
            f32x4 xv[2][8];
#pragma unroll
            for (int u2 = 0; u2 < 2; ++u2)
#pragma unroll
                for (int j = 0; j < 8; ++j) xv[u2][j] = ((const f32x4*)(X1 + (size_t)(t0 + wave * 8 + i + u2) * D) + lane)[64 * j];
#pragma unroll
            for (int u2 = 0; u2 < 2; ++u2) { const int tok = wave * 8 + i + u2; const float rstd = srstd[tok]; v2u* o = (v2u*)(H + (size_t)(t0 + tok) * D) + lane;
#pragma unroll
                for (int j = 0; j < 8; ++j) { const f32x4 hv = xv[u2][j] * rstd * av2[j] + bv2[j]; v2u pw; pw.x = pk2(hv.x, hv.y); pw.y = pk2(hv.z, hv.w); o[64 * j] = pw; } }
        }
    }
    __syncthreads();
}

__device__ __forceinline__ void p7_unit(const Frame& F, int u) {
    const int t0 = u * 64, tid = F.tid;
    const int* blkcnt = (const int*)(F.ws + WS_BLKCNT); int* slot = (int*)(F.ws + WS_SLOT); const int* eid = (const int*)(F.ws + WS_EID);
    LAS int* stot = (LAS int*)F.lds;
    LAS int* sbef = (LAS int*)(F.lds + 128);
    LAS int* sbase = (LAS int*)(F.lds + 256);
    LAS int* sslot = (LAS int*)(F.lds + 512);
    LAS int* scnt = (LAS int*)(F.lds + 1024);
    for (int i = tid; i < NCHUNK * 32 / 4; i += NTHR) *(LAS v4u*)(scnt + 4 * i) = *(const v4u*)(blkcnt + 4 * i);
    __syncthreads();
    if (tid < 32) { int tot = 0, bef = 0;
#pragma unroll 8
        for (int b = 0; b < NCHUNK; ++b) { const int v = scnt[b * 32 + tid]; tot += v; bef += (b < u) ? v : 0; } stot[tid] = tot; sbef[tid] = bef; }
    __syncthreads();
    if (tid == 0) { int ps = 0; for (int e = 0; e < 32; ++e) { sbase[e] = ps + sbef[e];
            if (u == 0) { int* tile_e = (int*)(F.ws + WS_TILE); for (int i = ps >> 8; i < ((ps + ((stot[e] + 255) & ~255)) >> 8); ++i) tile_e[i] = e; }
            ps += (stot[e] + 255) & ~255; }
        if (u == 0) ((int*)(F.ws + WS_TILE))[192] = ps >> 8; }
    __syncthreads();
    if (tid < 128) { const int s = sbase[eid[2 * t0 + tid]] + ((const int*)(F.ws + WS_RANK))[2 * t0 + tid]; sslot[tid] = s; slot[2 * t0 + tid] = s; }
    __syncthreads();
    const bf16* H = (const bf16*)(F.ws + WS_H); bf16* hs = (bf16*)(F.ws + WS_U);
    for (int i = 0; i < 16; ++i) { const int a = F.wave * 16 + i, s = sslot[a]; const v4u* src = (const v4u*)(H + (size_t)(t0 + (a >> 1)) * D) + F.lane; v4u* dst = (v4u*)(hs + (size_t)s * D) + F.lane;
#pragma unroll
        for (int j = 0; j < 4; ++j) dst[64 * j] = src[64 * j]; }
    __syncthreads();
}

__device__ __forceinline__ void p10_rows(const Frame& F, const Args& a) {
    const float* mod = (const float*)(F.ws + WS_MOD); const float* g2 = mod + 5 * D; const float* fw = a.in[IN_FNW];
    const int* slot = (const int*)(F.ws + WS_SLOT); const float* ew = (const float*)(F.ws + WS_EW); const bf16* yb = (const bf16*)(F.ws + WS_YB);
    float dbg = 0.f;
#if defined(MK_DEBUG_CHECK)
    dbg = __builtin_bit_cast(float, __hip_atomic_load((unsigned*)(F.ws + WS_CTL) + CW_DBG, __ATOMIC_RELAXED, __HIP_MEMORY_SCOPE_AGENT));
#endif
    const int gw = F.bid * NWAVES + F.wave, NGW = F.G * NWAVES;
    f32x4 gv[8], fv[8];
#pragma unroll
    for (int j = 0; j < 8; ++j) { const int k = 4 * F.lane + 256 * j; gv[j] = *(const f32x4*)(g2 + k); fv[j] = *(const f32x4*)(fw + k); }
    f32x4 nx[8]; v2u ny0[8], ny1[8]; float nw0 = 0.f, nw1 = 0.f;
#define P10_LOAD(row_) do { const int s0_ = slot[2 * (row_)], s1_ = slot[2 * (row_) + 1]; nw0 = ew[2 * (row_)]; nw1 = ew[2 * (row_) + 1]; \
        const float* xr_ = a.out + (size_t)(row_) * D; const v2u* y0_ = (const v2u*)(yb + (size_t)s0_ * D) + F.lane; const v2u* y1_ = (const v2u*)(yb + (size_t)s1_ * D) + F.lane; \
        _Pragma("unroll") for (int j = 0; j < 8; ++j) { nx[j] = *(const f32x4*)(xr_ + 4 * F.lane + 256 * j); ny0[j] = y0_[64 * j]; ny1[j] = y1_[64 * j]; } } while (0)
    if (gw < T) P10_LOAD(gw);
    for (int row = gw; row < T; row += NGW) {
        f32x4 v[8]; float s = 0.f; const float w0 = nw0, w1 = nw1;
#pragma unroll
        for (int j = 0; j < 8; ++j) { const v2u a0 = ny0[j], a1 = ny1[j];
            f32x4 m; m.x = w0 * bflo(a0.x) + w1 * bflo(a1.x); m.y = w0 * bfhi(a0.x) + w1 * bfhi(a1.x); m.z = w0 * bflo(a0.y) + w1 * bflo(a1.y); m.w = w0 * bfhi(a0.y) + w1 * bfhi(a1.y);
            v[j] = nx[j] + gv[j] * m; s += (v[j].x * v[j].x + v[j].y * v[j].y) + (v[j].z * v[j].z + v[j].w * v[j].w); }
        if (row + NGW < T) P10_LOAD(row + NGW);
        const float rstd = (1.f + dbg) / sqrtf(wave_sum(s) * (1.f / D) + EPS);
        float* xr = a.out + (size_t)row * D;
#pragma unroll
        for (int j = 0; j < 8; ++j) *(f32x4*)(xr + 4 * F.lane + 256 * j) = v[j] * rstd * fv[j];
    }
#undef P10_LOAD
}

constexpr int NPHASES = 12;
__global__ void __launch_bounds__(NTHR, 2) mk_fwd(Args args) {
    extern __shared__ __attribute__((aligned(16))) unsigned char lds_raw[];
    Frame F;
    F.lds = (LAS unsigned char*)lds_raw;
    F.tid = threadIdx.x; F.lane = F.tid & 63; F.wave = __builtin_amdgcn_readfirstlane(F.tid >> 6);
    F.G = gridDim.x; F.bid = blockIdx.x; F.vcu = (F.G % 8 == 0) ? (F.bid % 8) * (F.G / 8) + F.bid / 8 : F.bid;
    F.ws = args.ws;
    volatile LAS unsigned* MISC = (volatile LAS unsigned*)(F.lds + MISC_OFF);
    if (F.tid < 16) MISC[F.tid] = 0u;
    __syncthreads();
    const int lo = args.ph_lo, hi = args.ph_hi;
    XcdBarrier bar; bar.bar = (unsigned*)(F.ws + WS_CTL) + CW_BAR + args.li * XCD_BAR_WORDS; bar.x = 0; bar.st = nullptr;
    if (hi - lo > 1) bar = xcd_barrier_post((unsigned*)(F.ws + WS_CTL) + CW_BAR + args.li * XCD_BAR_WORDS, MISC + 8);
#define IN(k) (lo <= (k) && (k) < hi)
#define SEAM(k) do { if (IN(k) && IN((k) + 1)) xcd_barrier(bar); } while (0)
    float* mod = (float*)(F.ws + WS_MOD);

    if (IN(0)) { p0_ada(F, args.in[IN_C], args.in[IN_WADA], args.in[IN_BADA], mod); p0_convert(F, args); }
    SEAM(0);
    if (IN(1)) { norm_rows(F, args.in[IN_X], args.in[IN_N1W], mod + D, mod, (bf16*)(F.ws + WS_H)); p1_router_prep(F, args); }
    SEAM(1);
    if (IN(2)) {
        pg8::Gemm g{(const pg8::bf16_t*)(F.ws + WS_H), (const pg8::bf16_t*)(F.ws + WS_WIN), T, N_IN_PAD, D, 0}; ConvOrder S; S.init(T, N_IN_PAD, F.G, F.bid);
        S.J = ConvJob{args.in[IN_WG], args.in[IN_WU], args.in[IN_WD], (bf16*)(F.ws + WS_WGU), (bf16*)(F.ws + WS_WD)};
        const int nmy = (S.nwg - F.bid + F.G - 1) / F.G, gwv = F.bid * NWAVES + F.wave, per = 65536 / (F.G * NWAVES);
        S.pos = nmy > 0 ? (((F.bid >> 3) % 5) < nmy ? ((F.bid >> 3) % 5) : nmy - 1) : -1; S.it0 = gwv * per; S.nit = per;
        pg8::EpiU E{(pg8::bf16_t*)(F.ws + WS_U), (float*)(F.ws + WS_UDT)};
        pg8::gemm_phase<pg8::EpiU, ConvOrder, true, true>(F.lds, g, S, E);
        if (nmy <= 0) k8_convert(S.J, S.it0, S.nit, F.lane);
        for (int it = F.G * NWAVES * per + 2 * gwv; it < 65536; it += 2 * F.G * NWAVES) k8_convert(S.J, it, 2, F.lane);
    }
    SEAM(2);
    if (IN(3)) { for (int c = F.bid; c < NCHUNK; c += F.G) p3_chunk(F, args, c); }
    SEAM(3);
    if (IN(4)) p_scan(F);
    SEAM(4);
    if (IN(5)) { for (int u = F.bid; u < 2 * NCHUNK; u += F.G) p4_unit(F, args, u >> 1, u & 1); }
    SEAM(5);
    if (IN(6)) {
        pg8::Gemm g{(const pg8::bf16_t*)(F.ws + WS_YMIX), (const pg8::bf16_t*)(F.ws + WS_WOUT), T, D, D, 0}; ConvOrder S; S.init(T, D, F.G, F.bid);
        S.J = ConvJob{args.in[IN_WG], args.in[IN_WU], args.in[IN_WD], (bf16*)(F.ws + WS_WGU), (bf16*)(F.ws + WS_WD)};
        const int nmy = (S.nwg - F.bid + F.G - 1) / F.G, gwv = F.bid * NWAVES + F.wave, per = 32768 / (F.G * NWAVES);
        S.pos = nmy > 0 ? (((F.bid >> 3) & 1) < nmy ? ((F.bid >> 3) & 1) : nmy - 1) : -1; S.it0 = 65536 + gwv * per; S.nit = per;
        pg8::EpiX1 E{args.in[IN_X], args.out, mod + 2 * D};
        pg8::gemm_phase<pg8::EpiX1, ConvOrder, true, true>(F.lds, g, S, E);
        if (nmy <= 0) k8_convert(S.J, S.it0, S.nit, F.lane);
        for (int it = 65536 + F.G * NWAVES * per + 2 * gwv; it < 98304; it += 2 * F.G * NWAVES) k8_convert(S.J, it, 2, F.lane);
    }
    SEAM(6);
    if (IN(7)) { for (int u = F.bid; u < NCHUNK; u += F.G) p6_unit(F, args, u); }
    SEAM(7);
    if (IN(8)) { for (int u = F.bid; u < NCHUNK; u += F.G) p7_unit(F, u); }
    SEAM(8);
    if (IN(9)) {
        const int ntiles = __builtin_amdgcn_readfirstlane(__hip_atomic_load((int*)(F.ws + WS_TILE) + 192, __ATOMIC_RELAXED, __HIP_MEMORY_SCOPE_AGENT));
        pg8::Gemm g{(const pg8::bf16_t*)(F.ws + WS_U), (const pg8::bf16_t*)(F.ws + WS_WGU), ntiles * 256, 2048, D, (size_t)2048 * D * 2};
        pg8::MoeOrder S{(const int*)(F.ws + WS_TILE), ntiles * 8, 8, F.G, F.vcu};
        pg8::EpiHid E{(pg8::bf16_t*)(F.ws + WS_YMIX)};
        pg8::gemm_phase<pg8::EpiHid, pg8::MoeOrder, true, true, true>(F.lds, g, S, E);
    }
    SEAM(9);
    if (IN(10)) {
        const int ntiles = __builtin_amdgcn_readfirstlane(__hip_atomic_load((int*)(F.ws + WS_TILE) + 192, __ATOMIC_RELAXED, __HIP_MEMORY_SCOPE_AGENT));
        pg8::Gemm g{(const pg8::bf16_t*)(F.ws + WS_YMIX), (const pg8::bf16_t*)(F.ws + WS_WD), ntiles * 256, 2048, FF, (size_t)2048 * FF * 2};
        pg8::MoeOrder S{(const int*)(F.ws + WS_TILE), ntiles * 8, 8, F.G, F.vcu};
        pg8::EpiY E{(pg8::bf16_t*)(F.ws + WS_YB)};
        pg8::gemm_phase<pg8::EpiY, pg8::MoeOrder, true, true, true>(F.lds, g, S, E);
    }
    SEAM(10);
    if (IN(11)) p10_rows(F, args);
#undef IN
#undef SEAM
}

extern "C" void kernel_launch(void* const* d_in, const int* in_sizes, int n_in, void* d_out, int out_size, void* d_ws, size_t ws_size, hipStream_t stream) {
    static int grid = 0;
    if (grid == 0) {
        if (n_in != N_INPUTS || in_sizes[0] != T * D || out_size != T * D || ws_size < WS_END) { fprintf(stderr, "kernel_launch: unexpected shapes (n_in %d, in0 %d, out %d, ws %zu < %zu); nothing launched\n", n_in, n_in > 0 ? in_sizes[0] : -1, out_size, ws_size, (size_t)WS_END); grid = -1; return; }
        int dev = 0, cus = 0, per_cu = 0;
        if (hipGetDevice(&dev) != hipSuccess || hipDeviceGetAttribute(&cus, hipDeviceAttributeMultiprocessorCount, dev) != hipSuccess) { fprintf(stderr, "kernel_launch: device query failed\n"); grid = -1; return; }
        if (hipFuncSetAttribute((const void*)mk_fwd, hipFuncAttributeMaxDynamicSharedMemorySize, LDS_BYTES) != hipSuccess) { fprintf(stderr, "kernel_launch: hipFuncSetAttribute failed\n"); grid = -1; return; }
        if (hipOccupancyMaxActiveBlocksPerMultiprocessor(&per_cu, (const void*)mk_fwd, NTHR, LDS_BYTES) != hipSuccess || per_cu < 1) fprintf(stderr, "kernel_launch: note: occupancy query reports %d workgroups per CU\n", per_cu);
        (void)hipGetLastError();
        grid = cus;
    }
    if (grid < 0) return;
    if (hipMemsetAsync((char*)d_ws + WS_CTL, 0, CTL_ZERO_BYTES, stream) != hipSuccess) { fprintf(stderr, "kernel_launch: memset failed\n"); return; }
    Args a{};
    for (int i = 0; i < N_INPUTS; ++i) a.in[i] = (const float*)d_in[i];
    a.out = (float*)d_out; a.ws = (unsigned char*)d_ws;
#if defined(MK_PROBE) && MK_PROBE == 1
    static const int cuts[][2] = {{0, 1}, {0, 12}};
#elif defined(MK_PROBE) && MK_PROBE == 2
    static const int cuts[][2] = {{0, 3}, {1, 12}};
#elif defined(MK_PROBE) && MK_PROBE == 3
    static const int cuts[][2] = {{0, 6}, {3, 12}};
#elif defined(MK_PROBE) && MK_PROBE == 4
    static const int cuts[][2] = {{0, 8}, {6, 12}};
#elif defined(MK_PROBE) && MK_PROBE == 5
    static const int cuts[][2] = {{0, 11}, {9, 12}};
#elif defined(MK_PROBE) && MK_PROBE == 6
    static const int cuts[][2] = {{0, 4}, {3, 12}};
#elif defined(MK_PROBE) && MK_PROBE == 7
    static const int cuts[][2] = {{0, 6}, {5, 12}};
#elif defined(MK_PROBE) && MK_PROBE == 8
    static const int cuts[][2] = {{0, 8}, {7, 12}};
#elif defined(MK_PROBE) && MK_PROBE == 9
    static const int cuts[][2] = {{0, 7}, {6, 12}};
#elif defined(MK_PROBE) && MK_PROBE == 10
    static const int cuts[][2] = {{0, 9}, {8, 12}};
#elif defined(MK_PROBE) && MK_PROBE == 11
    static const int cuts[][2] = {{0, 5}, {12, 12}, {4, 12}};
#elif MK_N_LAUNCHES == 1
    static const int cuts[][2] = {{0, NPHASES}};
#else
    static const int cuts[][2] = {{0, 1}, {1, 2}, {2, 3}, {3, 4}, {4, 5}, {5, 6}, {6, 7}, {7, 8}, {8, 9}, {9, 10}, {10, 11}, {11, 12}};
#endif
    for (int li = 0; li < (int)(sizeof(cuts) / sizeof(cuts[0])); ++li) { a.ph_lo = cuts[li][0]; a.ph_hi = cuts[li][1]; a.li = li; hipLaunchKernelGGL(mk_fwd, dim3(grid), dim3(NTHR), LDS_BYTES, stream, a); }
    const hipError_t le = hipPeekAtLastError();
    if (le != hipSuccess) fprintf(stderr, "kernel_launch: launch failed: %s\n", hipGetErrorName(le));
}
```

```cpp
#include <hip/hip_runtime.h>
#include <cstdio>
#include <cstdint>

#ifndef MK_N_LAUNCHES
#define MK_N_LAUNCHES 1
#endif

namespace pg8 {
#define PG8_LAS __attribute__((address_space(3)))
typedef unsigned short bf16_t;
typedef short bf16x8 __attribute__((ext_vector_type(8)));
typedef float f32x4 __attribute__((ext_vector_type(4)));
typedef unsigned u32x4 __attribute__((ext_vector_type(4)));
constexpr int BM = 256, BK = 64, HALF = 128, HTB = HALF * BK * 2  , STAGE_BYTES = 8 * HTB, NXCD = 8, WGM = 8;

__host__ __device__ __forceinline__ int lds_byte(int r, int c) { const int st = (r >> 4) * 2 + (c >> 5), rr = r & 15, cc = c & 31, ob = rr * 64 + cc * 2; return st * 1024 + (ob ^ (((ob >> 9) & 1) << 5)); }
__host__ __device__ __forceinline__ void stage_rc(int b, int& R, int& C) { const int st = b / 1024, sb = b % 1024, swz = sb ^ (((sb >> 9) & 1) << 5); R = (st >> 1) * 16 + swz / 64; C = (st & 1) * 32 + (swz % 64) / 2; }
__host__ __device__ __forceinline__ int perm32(int rho) { const int n = rho >> 4, i = rho & 15; return 8 * (i >> 2) + 4 * n + (i & 3); }

struct Unit { int pm, pn, pb, pe; };
struct Gemm { const bf16_t* A; const bf16_t* Bt; int M, N, K; size_t estep; };

struct StaticOrder {
    int nM, nN, nwg, G, c;
    __host__ __device__ void init(int M, int N, int G_, int c_) { nM = M / BM; nN = N / BM; nwg = nM * nN; G = G_; c = c_; }
    __host__ __device__ bool next(int i, Unit& u) const {
        const long L = (long)i * G + c; if (L >= nwg) return false;
        int wgid = (int)L; { const int q = nwg / NXCD, r = nwg % NXCD, xcd = wgid % NXCD, off = wgid / NXCD; wgid = (xcd < r ? xcd * (q + 1) : r * (q + 1) + (xcd - r) * q) + off; }
        const int nig = WGM * nN, gid = wgid / nig, fm = gid * WGM, gsz = (nM - fm) < WGM ? (nM - fm) : WGM;
        u.pm = fm + ((wgid % nig) % gsz); u.pn = (wgid % nig) / gsz; u.pb = u.pn; u.pe = 0; return true;
    }
    __device__ __forceinline__ void a_ready(const Unit&) const {}
    __device__ __forceinline__ void done(const Unit&, int) const {}
};
struct MoeOrder {
    const int* tile_e; int nunits, ncol, G, c;
    __device__ bool next(int i, Unit& u) const {
        const long L = (long)i * G + c; if (L >= nunits) return false;
        u.pm = (int)L / ncol; u.pn = (int)L % ncol;
        const int e = __builtin_amdgcn_readfirstlane(__hip_atomic_load((int*)tile_e + u.pm, __ATOMIC_RELAXED, __HIP_MEMORY_SCOPE_AGENT));
        u.pb = u.pn; u.pe = e; return true;
    }
    __device__ __forceinline__ void a_ready(const Unit&) const {}
    __device__ __forceinline__ void done(const Unit&, int) const {}
};

typedef float f32x2_t __attribute__((ext_vector_type(2)));
typedef __bf16 bf16x2_t __attribute__((ext_vector_type(2)));
__device__ __forceinline__ unsigned cvt_pk_bf16(float lo, float hi) { const f32x2_t v = {lo, hi}; const bf16x2_t b = __builtin_convertvector(v, bf16x2_t); return __builtin_bit_cast(unsigned, b); }

struct EpiU {
    static constexpr bool PERM = true, AFTER_DRAIN = false;
    bf16_t* U; float* udt;
    __device__ __forceinline__ void operator()(const f32x4 (&acc)[2][2][4][2], const Unit& u, int wr, int wc, int fr, int fq) const {
        const int row0 = u.pm * BM + wr * 64 + fr;
        if (u.pn < 22) {
            const int col0 = u.pn * BM + wc * 32 + 8 * fq;
#pragma unroll
            for (int ai = 0; ai < 2; ++ai)
#pragma unroll
                for (int m = 0; m < 4; ++m) { bf16_t* rowp = U + (size_t)(row0 + ai * HALF + m * 16) * 5632 + col0;
#pragma unroll
                    for (int bj = 0; bj < 2; ++bj) { const f32x4 v0 = acc[ai][bj][m][0], v1 = acc[ai][bj][m][1];
                        u32x4 w; w.x = cvt_pk_bf16(v0[0], v0[1]); w.y = cvt_pk_bf16(v0[2], v0[3]); w.z = cvt_pk_bf16(v1[0], v1[1]); w.w = cvt_pk_bf16(v1[2], v1[3]);
                        *(u32x4*)(rowp + bj * HALF) = w; } }
        } else if (wc == 0 && fq < 2) {
#pragma unroll
            for (int ai = 0; ai < 2; ++ai)
#pragma unroll
                for (int m = 0; m < 4; ++m) { float* rowp = udt + (size_t)(row0 + ai * HALF + m * 16) * 16 + 8 * fq;
                    *(f32x4*)(rowp) = acc[ai][0][m][0]; *(f32x4*)(rowp + 4) = acc[ai][0][m][1]; }
        }
    }
};
struct EpiX1 {
    static constexpr bool PERM = false, AFTER_DRAIN = false;
    const float* X; float* O; const float* gate;
    __device__ __forceinline__ void operator()(const f32x4 (&acc)[2][2][4][2], const Unit& u, int wr, int wc, int fr, int fq) const {
        const int row0 = u.pm * BM + wr * 64 + fr, col0 = u.pn * BM + wc * 32 + 4 * fq;
        f32x4 gv[2][2];
#pragma unroll
        for (int bj = 0; bj < 2; ++bj)
#pragma unroll
            for (int n = 0; n < 2; ++n) gv[bj][n] = *(const f32x4*)(gate + col0 + bj * HALF + n * 16);
#pragma unroll
        for (int ai = 0; ai < 2; ++ai)
#pragma unroll
            for (int m = 0; m < 4; ++m) { const size_t ro = (size_t)(row0 + ai * HALF + m * 16) * 2048 + col0;
#pragma unroll
                for (int bj = 0; bj < 2; ++bj)
#pragma unroll
                    for (int n = 0; n < 2; ++n) { const f32x4 xv = *(const f32x4*)(X + ro + bj * HALF + n * 16);
                        *(f32x4*)(O + ro + bj * HALF + n * 16) = xv + gv[bj][n] * acc[ai][bj][m][n]; } }
    }
};
struct EpiHid {
    static constexpr bool PERM = true, AFTER_DRAIN = false;
    bf16_t* Hd;
    __device__ __forceinline__ void operator()(const f32x4 (&acc)[2][2][4][2], const Unit& u, int wr, int wc, int fr, int fq) const {
        const int row0 = u.pm * BM + wr * 64 + fr, col0 = u.pn * HALF + wc * 32 + 8 * fq;
#pragma unroll
        for (int ai = 0; ai < 2; ++ai)
#pragma unroll
            for (int m = 0; m < 4; ++m) { bf16_t* rowp = Hd + (size_t)(row0 + ai * HALF + m * 16) * 1024 + col0;
                float r[8];
#pragma unroll
                for (int n = 0; n < 2; ++n)
#pragma unroll
                    for (int j = 0; j < 4; ++j) { const float g = acc[ai][0][m][n][j], up = acc[ai][1][m][n][j]; r[4 * n + j] = g / (1.f + __expf(-g)) * up; }
                u32x4 w; w.x = cvt_pk_bf16(r[0], r[1]); w.y = cvt_pk_bf16(r[2], r[3]); w.z = cvt_pk_bf16(r[4], r[5]); w.w = cvt_pk_bf16(r[6], r[7]);
                *(u32x4*)(rowp) = w; }
    }
};
struct EpiY {
    static constexpr bool PERM = true, AFTER_DRAIN = false;
    bf16_t* Y;
    __device__ __forceinline__ void operator()(const f32x4 (&acc)[2][2][4][2], const Unit& u, int wr, int wc, int fr, int fq) const {
        const int row0 = u.pm * BM + wr * 64 + fr, col0 = u.pn * BM + wc * 32 + 8 * fq;
#pragma unroll
        for (int ai = 0; ai < 2; ++ai)
#pragma unroll
            for (int m = 0; m < 4; ++m) { bf16_t* rowp = Y + (size_t)(row0 + ai * HALF + m * 16) * 2048 + col0;
#pragma unroll
                for (int bj = 0; bj < 2; ++bj) { const f32x4 v0 = acc[ai][bj][m][0], v1 = acc[ai][bj][m][1];
                    u32x4 w; w.x = cvt_pk_bf16(v0[0], v0[1]); w.y = cvt_pk_bf16(v0[2], v0[3]); w.z = cvt_pk_bf16(v1[0], v1[1]); w.w = cvt_pk_bf16(v1[2], v1[3]);
                    *(u32x4*)(rowp + bj * HALF) = w; } }
    }
};

template <class Epi, class Sched, bool ALIGN_EPI = false, bool SP2 = false, bool BK8 = false>
__device__ __forceinline__ void gemm_phase(PG8_LAS unsigned char* lds, const Gemm g, const Sched& S, const Epi& E) {
    const int tid = threadIdx.x, wid = __builtin_amdgcn_readfirstlane(tid >> 6), lane = tid & 63, wr = wid >> 2, wc = wid & 3, fr = lane & 15, fq = lane >> 4;
    const int K = g.K, nt = K / BK;
    unsigned voffA[2], voffB[2];
#pragma unroll
    for (int i = 0; i < 2; ++i) { int R, C; stage_rc(tid * 16 + i * 8192, R, C); const int Rb = Epi::PERM ? ((R & ~31) + perm32(R & 31)) : R;
        voffA[i] = (unsigned)(R * K + C) * 2u; voffB[i] = BK8 ? (unsigned)((C >> 3) * g.N + Rb) * 16u : (unsigned)(Rb * K + C) * 2u; }
    const size_t kstepA = (size_t)(BK * 2), hstepA = (size_t)HALF * K * 2, tstepA = 2 * hstepA;
    const size_t kstepB = BK8 ? (size_t)128 * g.N : (size_t)(BK * 2), hstepB = BK8 ? (size_t)2048 : (size_t)HALF * K * 2;
#define PG8_BBASE(u) ((const char*)g.Bt + (BK8 ? (size_t)(u).pe * g.estep + (size_t)(u).pb * 4096 : (size_t)(u).pb * 2 * hstepB))
    const unsigned ldsw = (unsigned)wid * 1024u;
    const int aoff = lds_byte(wr * 64 + fr, fq * 8), boff = lds_byte(wc * 32 + fr, fq * 8);
#define PG8_SA(b, h) (((b) * 2 + (h)) * HTB)
#define PG8_SB(b, h) ((4 + (b) * 2 + (h)) * HTB)
#define PG8_STAGE(bufoff, gbase, voff) do { _Pragma("unroll") for (int _i = 0; _i < 2; ++_i) \
        __builtin_amdgcn_global_load_lds((const unsigned*)((const char*)(gbase) + (voff)[_i]), (PG8_LAS unsigned*)(lds + (bufoff) + ldsw + _i * 8192), 16, 0, 0); } while (0)
#define PG8_LDA(dst, b, h) do { _Pragma("unroll") for (int m = 0; m < 4; ++m) _Pragma("unroll") for (int k = 0; k < 2; ++k) dst[m][k] = *(const PG8_LAS bf16x8*)(lds + PG8_SA(b, h) + aoff + m * 2048 + k * 1024); } while (0)
#define PG8_LDB(dst, b, h) do { _Pragma("unroll") for (int n = 0; n < 2; ++n) _Pragma("unroll") for (int k = 0; k < 2; ++k) dst[n][k] = *(const PG8_LAS bf16x8*)(lds + PG8_SB(b, h) + boff + n * 2048 + k * 1024); } while (0)
#define PG8_MMA(ai, bj, At, Bt) do { __builtin_amdgcn_s_setprio(1); _Pragma("unroll") for (int m = 0; m < 4; ++m) _Pragma("unroll") for (int n = 0; n < 2; ++n) _Pragma("unroll") for (int k = 0; k < 2; ++k) \
        acc[ai][bj][m][n] = __builtin_amdgcn_mfma_f32_16x16x32_bf16(Bt[n][k], At[m][k], acc[ai][bj][m][n], 0, 0, 0); __builtin_amdgcn_s_setprio(0); } while (0)
#define PG8_WAIT_V(n) asm volatile("s_waitcnt vmcnt(" #n ")" ::: "memory")
#define PG8_WAIT_L(n) asm volatile("s_waitcnt lgkmcnt(" #n ")" ::: "memory")
#define PG8_BAR __builtin_amdgcn_s_barrier()
#define PG8_SCHED __builtin_amdgcn_sched_barrier(0)
    Unit cur, nxt; int ui = 0;
    if (!S.next(0, cur)) return;
    f32x4 acc[2][2][4][2];
#pragma unroll
    for (int a = 0; a < 2; ++a)
#pragma unroll
        for (int b = 0; b < 2; ++b)
#pragma unroll
            for (int m = 0; m < 4; ++m)
#pragma unroll
                for (int n = 0; n < 2; ++n) acc[a][b][m][n] = (f32x4){0.f, 0.f, 0.f, 0.f};
    bf16x8 At[4][2], B0[2][2], B1[2][2];
    const char* cA = (const char*)g.A + (size_t)cur.pm * tstepA; const char* cB = PG8_BBASE(cur);
    S.a_ready(cur);
    if constexpr (SP2) {
        PG8_STAGE(PG8_SB(0, 0), cB, voffB); PG8_STAGE(PG8_SB(0, 1), cB + hstepB, voffB); PG8_STAGE(PG8_SA(0, 0), cA, voffA); PG8_STAGE(PG8_SA(0, 1), cA + hstepA, voffA);
        if (wr == 1) PG8_BAR;
        PG8_WAIT_V(2); PG8_BAR;
        PG8_STAGE(PG8_SB(1, 0), cB + kstepB, voffB); PG8_STAGE(PG8_SA(1, 0), cA + kstepA, voffA); PG8_STAGE(PG8_SB(1, 1), cB + hstepB + kstepB, voffB);
        PG8_WAIT_V(6); PG8_BAR;
    } else {
        PG8_STAGE(PG8_SB(0, 0), cB, voffB); PG8_STAGE(PG8_SA(0, 0), cA, voffA); PG8_STAGE(PG8_SB(0, 1), cB + hstepB, voffB); PG8_STAGE(PG8_SA(0, 1), cA + hstepA, voffA);
        if (wr == 1) PG8_BAR;
        PG8_WAIT_V(4); PG8_BAR;
        PG8_STAGE(PG8_SB(1, 0), cB + kstepB, voffB); PG8_STAGE(PG8_SA(1, 0), cA + kstepA, voffA); PG8_STAGE(PG8_SB(1, 1), cB + hstepB + kstepB, voffB);
        PG8_WAIT_V(6); PG8_BAR;
    }
    for (;;) {
        const bool has_next = S.next(ui + 1, nxt);
        const char* nA = has_next ? (const char*)g.A + (size_t)nxt.pm * tstepA : cA; const char* nB = has_next ? PG8_BBASE(nxt) : cB;
        for (int t = 0; t < nt; t += 2) {
            const bool last = (t == nt - 2);
            const char* a1 = cA + (size_t)(t + 1) * kstepA;
            const char* a2 = last ? nA : cA + (size_t)(t + 2) * kstepA; const char* b2 = last ? nB : cB + (size_t)(t + 2) * kstepB;
            const char* a3 = a2 + kstepA; const char* b3 = b2 + kstepB;
            if (last && has_next) S.a_ready(nxt);
            if constexpr (SP2) {
            PG8_LDB(B0, 0, 0); PG8_LDB(B1, 0, 1); PG8_SCHED; PG8_LDA(At, 0, 0); PG8_STAGE(PG8_SA(1, 1), a1 + hstepA, voffA);
            PG8_WAIT_V(8); PG8_WAIT_L(0); PG8_BAR; PG8_MMA(0, 0, At, B0); PG8_MMA(0, 1, At, B1); PG8_BAR; PG8_SCHED;
            PG8_LDA(At, 0, 1); PG8_STAGE(PG8_SB(0, 0), b2, voffB); PG8_STAGE(PG8_SB(0, 1), b2 + hstepB, voffB); PG8_STAGE(PG8_SA(0, 0), a2, voffA);
            PG8_WAIT_V(8); PG8_WAIT_L(0); PG8_BAR; PG8_MMA(1, 0, At, B0); PG8_MMA(1, 1, At, B1); PG8_BAR; PG8_SCHED;
            PG8_LDB(B0, 1, 0); PG8_LDB(B1, 1, 1); PG8_SCHED; PG8_LDA(At, 1, 0); PG8_STAGE(PG8_SA(0, 1), a2 + hstepA, voffA);
            PG8_WAIT_V(8); PG8_WAIT_L(0); PG8_BAR; PG8_MMA(0, 0, At, B0); PG8_MMA(0, 1, At, B1); PG8_BAR; PG8_SCHED;
            PG8_LDA(At, 1, 1); PG8_STAGE(PG8_SB(1, 0), b3, voffB); PG8_STAGE(PG8_SB(1, 1), b3 + hstepB, voffB); PG8_STAGE(PG8_SA(1, 0), a3, voffA);
            PG8_WAIT_V(8); PG8_WAIT_L(0); PG8_BAR; PG8_MMA(1, 0, At, B0); PG8_MMA(1, 1, At, B1); PG8_BAR; PG8_SCHED;
            } else {
            PG8_LDB(B0, 0, 0); PG8_SCHED; PG8_LDA(At, 0, 0); PG8_STAGE(PG8_SA(1, 1), a1 + hstepA, voffA);
            PG8_WAIT_L(8); PG8_BAR; PG8_WAIT_L(0); PG8_MMA(0, 0, At, B0); PG8_BAR; PG8_SCHED;
            PG8_LDB(B1, 0, 1); PG8_STAGE(PG8_SB(0, 0), b2, voffB);
            PG8_BAR; PG8_WAIT_L(0); PG8_MMA(0, 1, At, B1); PG8_BAR;
            PG8_LDA(At, 0, 1); PG8_STAGE(PG8_SA(0, 0), a2, voffA);
            PG8_BAR; PG8_WAIT_L(0); PG8_MMA(1, 0, At, B0); PG8_BAR; PG8_SCHED;
            PG8_STAGE(PG8_SB(0, 1), b2 + hstepB, voffB);
            PG8_WAIT_V(6); PG8_BAR; PG8_MMA(1, 1, At, B1); PG8_BAR;
            PG8_LDB(B0, 1, 0); PG8_SCHED; PG8_LDA(At, 1, 0); PG8_STAGE(PG8_SA(0, 1), a2 + hstepA, voffA);
            PG8_WAIT_L(8); PG8_BAR; PG8_WAIT_L(0); PG8_MMA(0, 0, At, B0); PG8_BAR; PG8_SCHED;
            PG8_LDB(B1, 1, 1); PG8_STAGE(PG8_SB(1, 0), b3, voffB);
            PG8_BAR; PG8_WAIT_L(0); PG8_MMA(0, 1, At, B1); PG8_BAR;
            PG8_LDA(At, 1, 1); PG8_STAGE(PG8_SA(1, 0), a3, voffA);
            PG8_BAR; PG8_WAIT_L(0); PG8_MMA(1, 0, At, B0); PG8_BAR; PG8_SCHED;
            PG8_STAGE(PG8_SB(1, 1), b3 + hstepB, voffB);
            PG8_WAIT_V(6); PG8_BAR; PG8_MMA(1, 1, At, B1); PG8_BAR;
            }
        }
        if constexpr (ALIGN_EPI) { if (wr == 0) PG8_BAR; }
        if constexpr (!Epi::AFTER_DRAIN) { E(acc, cur, wr, wc, fr, fq); S.done(cur, ui); }
        if (!has_next) break;
#pragma unroll
        for (int a = 0; a < 2; ++a)
#pragma unroll
            for (int b = 0; b < 2; ++b)
#pragma unroll
                for (int m = 0; m < 4; ++m)
#pragma unroll
                    for (int n = 0; n < 2; ++n) acc[a][b][m][n] = (f32x4){0.f, 0.f, 0.f, 0.f};
        cur = nxt; cA = nA; cB = nB; ++ui;
        if constexpr (ALIGN_EPI) { if (wr == 1) PG8_BAR; }
    }
    PG8_WAIT_V(0);
    if constexpr (!ALIGN_EPI) { if (wr == 0) PG8_BAR; }
    PG8_BAR;
    if constexpr (Epi::AFTER_DRAIN) { E.fused(acc, cur, wr, wc, fr, fq, lds, wid, lane); S.done(cur, ui); }
#undef PG8_BBASE
#undef PG8_SA
#undef PG8_SB
#undef PG8_STAGE
#undef PG8_LDA
#undef PG8_LDB
#undef PG8_MMA
#undef PG8_WAIT_V
#undef PG8_WAIT_L
#undef PG8_BAR
#undef PG8_SCHED
}
}
#define XB_TMO      128
#define XB_XCNT(j)  (256  + 64 * (j))
#define XB_XSUB(j)  (1280 + 64 * (j))
#define XB_XGEN(j)  (2304 + 64 * (j))
#define XB_TOP      3328
#define XB_TOPGEN   3392
#define XCD_BAR_WORDS 3456
#define XB_SPIN_CAP (1u << 18)
#define LAS __attribute__((address_space(3)))

__device__ __forceinline__ unsigned xb_ld(unsigned* p)              { return __hip_atomic_load(p, __ATOMIC_RELAXED, __HIP_MEMORY_SCOPE_AGENT); }
__device__ __forceinline__ unsigned xb_add(unsigned* p, unsigned v) { return __hip_atomic_fetch_add(p, v, __ATOMIC_RELAXED, __HIP_MEMORY_SCOPE_AGENT); }
__device__ __forceinline__ unsigned xb_xcc_id() { return (unsigned)__builtin_amdgcn_s_getreg((3 << 11) | 20) & 0xFu; }
#define XB_SPIN(cond, bar) do { unsigned _sp = 0; while (cond) { __builtin_amdgcn_s_sleep(1); \
    if ((++_sp & 255u) == 0u) { if (xb_ld(&(bar)[XB_TMO])) break; if (_sp > XB_SPIN_CAP) { atomicAdd(&(bar)[XB_TMO], 1u); break; } } } } while (0)

struct XcdBarrier {
    unsigned* bar; unsigned x;
    volatile LAS unsigned* st;
};

__device__ __forceinline__ XcdBarrier xcd_barrier_post(unsigned* bar, volatile LAS unsigned* st) {
    XcdBarrier b; b.bar = bar; b.x = xb_xcc_id(); b.st = st;
    if (threadIdx.x == 0) (void)xb_add(&bar[XB_XCNT(b.x)], 1u);
    return b;
}
__device__ __forceinline__ void xcd_barrier_complete(unsigned* bar, unsigned x, unsigned& nloc, unsigned& nx) {
    const unsigned G = gridDim.x * gridDim.y * gridDim.z;
    unsigned sum, cnt, mine, sp = 0u;
    for (;;) {
        sum = 0u; cnt = 0u; mine = 0u;
#pragma unroll
        for (unsigned j = 0; j < 16; ++j) { const unsigned c = xb_ld(&bar[XB_XCNT(j)]); sum += c; cnt += (c > 0u) ? 1u : 0u; mine = (j == x) ? c : mine; }
        if (sum == G) break;
        __builtin_amdgcn_s_sleep(1);
        if ((++sp & 255u) == 0u) { if (xb_ld(&bar[XB_TMO])) break; if (sp > XB_SPIN_CAP) { atomicAdd(&bar[XB_TMO], 1u); break; } }
    }
    nloc = mine > 0u ? mine : 1u; nx = cnt > 0u ? cnt : 1u;
}

__device__ __forceinline__ void xcd_barrier(const XcdBarrier& b) {
    asm volatile("s_waitcnt vmcnt(0)" ::: "memory");
    __syncthreads();
    if (threadIdx.x == 0) {
        unsigned* bar = b.bar;
        __builtin_amdgcn_s_waitcnt(0);
        unsigned nloc = b.st[0], nx = b.st[1];
        if (nloc == 0u) { xcd_barrier_complete(bar, b.x, nloc, nx); b.st[0] = nloc; b.st[1] = nx; }
        const unsigned old = xb_add(&bar[XB_XSUB(b.x)], 1u);
        const unsigned gen = old / nloc;
        if (old + 1u == (gen + 1u) * nloc) {
            __builtin_amdgcn_fence(__ATOMIC_RELEASE, "agent");
            asm volatile("s_waitcnt vmcnt(0)" ::: "memory");
            const unsigned og = xb_add(&bar[XB_TOP], 1u);
            const unsigned tg = og / nx;
            if (og + 1u == (tg + 1u) * nx) xb_add(&bar[XB_TOPGEN], 1u);
            else XB_SPIN(xb_ld(&bar[XB_TOPGEN]) == tg, bar);
            __builtin_amdgcn_fence(__ATOMIC_ACQUIRE, "agent");
            xb_add(&bar[XB_XGEN(b.x)], 1u);
            asm volatile("s_waitcnt vmcnt(0)" ::: "memory");
        } else {
            XB_SPIN(xb_ld(&bar[XB_XGEN(b.x)]) == gen, bar);
            __builtin_amdgcn_fence(__ATOMIC_ACQUIRE, "agent");
            asm volatile("s_waitcnt vmcnt(0)" ::: "memory");
        }
    }
    __syncthreads();
}

constexpr int T = 16384, D = 2048, NTHR = 512, NWAVES = 8;
constexpr int NU = 5632;
constexpr int N_IN = 5648, N_IN_PAD = 5888;
constexpr int NCHUNK = 256;
constexpr int NE = 32, FF = 1024;
constexpr int MAX_TILES = 160;
constexpr float EPS = 1e-6f;
enum { IN_X = 0, IN_C, IN_WADA, IN_BADA, IN_N1W, IN_WIN, IN_CONVW, IN_SCONVW, IN_SCONVB, IN_DTB, IN_ALOG, IN_DSKIP, IN_SNW, IN_WOUT, IN_N2W, IN_WRG, IN_BRG, IN_WRE, IN_BRE, IN_WG, IN_WU, IN_WD, IN_FNW, N_INPUTS };

constexpr size_t KiB = 1024, MiB = 1u << 20;
constexpr size_t WS_CTL = 0, CTL_ZERO_BYTES = 1 * MiB;
constexpr size_t WS_MOD = 1 * MiB;
constexpr size_t WS_BIAS2 = 1 * MiB + 56 * KiB;
constexpr size_t WS_W2T = 1 * MiB + 64 * KiB;
constexpr size_t WS_BLKCNT = 1536 * KiB;
constexpr size_t WS_TILE = 1600 * KiB;
constexpr size_t WS_SLOT = 1664 * KiB;
constexpr size_t WS_EW = 1792 * KiB;
constexpr size_t WS_EID = 1920 * KiB;
constexpr size_t WS_RANK = 5 * MiB;
constexpr size_t WS_DT = 2 * MiB, WS_ACS = 3 * MiB, WS_UDT = 4 * MiB;
constexpr size_t WS_WIN = 8 * MiB;
constexpr size_t WS_WOUT = 32 * MiB;
constexpr size_t WS_WGU = 40 * MiB;
constexpr size_t WS_WD = 296 * MiB;
constexpr size_t WS_H = 424 * MiB;
constexpr size_t WS_U = 488 * MiB;
constexpr size_t WS_YMIX = 664 * MiB;
constexpr size_t WS_XS = 744 * MiB;
constexpr size_t WS_BM = 776 * MiB, WS_CM = 784 * MiB;
constexpr size_t WS_ST = 792 * MiB;
constexpr size_t WS_BMT = 856 * MiB;
constexpr size_t WS_YB = 744 * MiB;
constexpr size_t WS_END = 904 * MiB;
constexpr int CW_DBG = 16;
constexpr int CW_BAR = 4096;

constexpr int RING_BYTES = 131072;
constexpr int MISC_OFF = 131072;
constexpr int LDS_BYTES = 131072 + 1024;

#define GAS __attribute__((address_space(1)))
typedef unsigned short bf16;
typedef unsigned v4u __attribute__((ext_vector_type(4)));
typedef unsigned v2u __attribute__((ext_vector_type(2)));
typedef float f32x4 __attribute__((ext_vector_type(4)));
#define LDS_WAIT() asm volatile("s_waitcnt lgkmcnt(0)" ::: "memory")
__device__ __forceinline__ float bflo(unsigned u) { return __builtin_bit_cast(float, u << 16); }
__device__ __forceinline__ float bfhi(unsigned u) { return __builtin_bit_cast(float, u & 0xffff0000u); }
__device__ __forceinline__ unsigned pk2(float lo, float hi) { return pg8::cvt_pk_bf16(lo, hi); }
__device__ __forceinline__ float wave_sum(float v) {
#pragma unroll
    for (int o = 1; o < 64; o <<= 1) v += __shfl_xor(v, o);
    return v;
}
__device__ __forceinline__ float silu_f(float v) { return v / (1.f + __expf(-v)); }

struct Args { const float* in[N_INPUTS]; float* out; unsigned char* ws; int ph_lo, ph_hi, li, pad; };

struct Frame {
    LAS unsigned char* lds;
    int tid, lane, wave, G, vcu, bid;
    unsigned char* ws;
};

struct ConvJob { const float* wg; const float* wu; const float* wd; bf16* dgu; bf16* dd; };
__device__ __forceinline__ void k8_item_addr(const ConvJob& J, int id, int lane, const float*& src, int& ldw, bf16*& dst) {
    if (id < 65536) { const int up = id >> 15, r0 = id & 32767, e = r0 >> 10, r = r0 & 1023, kb = r >> 2, nb = r & 3, n = nb * 256 + 4 * lane;
        src = (up ? J.wu : J.wg) + (size_t)e * D * FF + (size_t)(kb * 8) * FF + n; ldw = FF;
        const int drow = ((n >> 7) << 8) + (up ? 128 : 0) + (n & 127);
        dst = J.dgu + (size_t)e * 2048 * D + ((size_t)kb * 2048 + drow) * 8; }
    else { const int r0 = id - 65536, e = r0 >> 10, r = r0 & 1023, kb = r >> 3, nb = r & 7, n = nb * 256 + 4 * lane;
        src = J.wd + (size_t)e * FF * D + (size_t)(kb * 8) * D + n; ldw = D;
        dst = J.dd + (size_t)e * 2048 * FF + ((size_t)kb * 2048 + n) * 8; }
}
__device__ __forceinline__ void k8_convert(const ConvJob& J, int it0, int nit, int lane) {
#pragma unroll 1
    for (int it = it0; it < it0 + nit; it += 2) {
        const float* s0; const float* s1; int l0, l1; bf16* d0; bf16* d1;
        k8_item_addr(J, it, lane, s0, l0, d0); k8_item_addr(J, it + 1, lane, s1, l1, d1);
        f32x4 v0[8], v1[8];
#pragma unroll
        for (int i = 0; i < 8; ++i) { v0[i] = *(const f32x4*)(s0 + (size_t)i * l0); v1[i] = *(const f32x4*)(s1 + (size_t)i * l1); }
#pragma unroll
        for (int j = 0; j < 4; ++j) { v4u o; o.x = pk2(v0[0][j], v0[1][j]); o.y = pk2(v0[2][j], v0[3][j]); o.z = pk2(v0[4][j], v0[5][j]); o.w = pk2(v0[6][j], v0[7][j]); *(v4u*)(d0 + j * 8) = o; }
#pragma unroll
        for (int j = 0; j < 4; ++j) { v4u o; o.x = pk2(v1[0][j], v1[1][j]); o.y = pk2(v1[2][j], v1[3][j]); o.z = pk2(v1[4][j], v1[5][j]); o.w = pk2(v1[6][j], v1[7][j]); *(v4u*)(d1 + j * 8) = o; }
    }
}
struct ConvOrder : pg8::StaticOrder {
    ConvJob J; int pos, it0, nit;
    __device__ __forceinline__ void done(const pg8::Unit&, int ui) const { if (ui == pos) k8_convert(J, it0, nit, (int)(threadIdx.x & 63)); }
};

__device__ __forceinline__ void p0_ada(const Frame& F, const float* cvec, const float* w_ada, const float* b_ada, float* mod) {
    LAS float* red = (LAS float*)F.lds;
    const int kq = F.tid / 12, cq = F.tid % 12;
    for (int chunk = F.vcu; chunk < 256; chunk += F.G) {
        if (F.tid < 504) {
            f32x4 acc = (f32x4){0.f, 0.f, 0.f, 0.f};
            const float* wp = w_ada + 48 * chunk + 4 * cq;
#pragma unroll 7
            for (int i = 0; i < 49; ++i) {
                const int k = kq + 42 * i; const bool ok = k < D; const int kk = ok ? k : 0;
                const float cv = cvec[kk]; const float s = ok ? cv / (1.f + expf(-cv)) : 0.f;
                const f32x4 w = *(const f32x4*)(wp + (size_t)kk * 12288);
                acc += s * w;
            }
            *(LAS f32x4*)(red + kq * 48 + 4 * cq) = acc;
        }
        __syncthreads();
        if (F.tid < 48) { float s = 0.f; for (int q = 0; q < 42; ++q) s += red[q * 48 + F.tid]; mod[48 * chunk + F.tid] = s + b_ada[48 * chunk + F.tid]; }
        __syncthreads();
    }
}
__device__ __forceinline__ void tr_item(const float* W, int ldw, int nvalid, int k0, int n0, bf16* dst, int ldd, LAS float* scr, int lane) {
    const int nn = n0 + (lane & 31); const bool ok = nn < nvalid; const int nc = ok ? nn : 0;
#pragma unroll 8
    for (int i = 0; i < 32; ++i) { const int kk = 2 * i + (lane >> 5); const float v = W[(size_t)(k0 + kk) * ldw + nc]; scr[kk * 33 + (lane & 31)] = ok ? v : 0.f; }
    LDS_WAIT();
    const int c = lane & 7;
#pragma unroll
    for (int j = 0; j < 4; ++j) { const int n = (lane >> 3) + 8 * j; const LAS float* s = scr + (8 * c) * 33 + n;
        v4u o; o.x = pk2(s[0 * 33], s[1 * 33]); o.y = pk2(s[2 * 33], s[3 * 33]); o.z = pk2(s[4 * 33], s[5 * 33]); o.w = pk2(s[6 * 33], s[7 * 33]);
        *(v4u*)(dst + (size_t)n * ldd + k0 + 8 * c) = o; }
    LDS_WAIT();
}
__device__ __forceinline__ void p0_convert(const Frame& F, const Args& a) {
    LAS float* scr = (LAS float*)(F.lds + 16384 + F.wave * 8704);
    bf16* Wt_in = (bf16*)(F.ws + WS_WIN); bf16* Wt_out = (bf16*)(F.ws + WS_WOUT);
    constexpr int I_IN = 32 * 177, I_OUT = 32 * 64, NITEMS = I_IN + I_OUT;
    const int gw = F.bid * NWAVES + F.wave, NGW = F.G * NWAVES;
    for (int it = gw; it < NITEMS; it += NGW) {
        int r = it;
        if (r < I_IN) { const int kb = r / 177, nb = r % 177; tr_item(a.in[IN_WIN], N_IN, N_IN, 64 * kb, 32 * nb, Wt_in + (size_t)(32 * nb) * D, D, scr, F.lane); continue; } r -= I_IN;
        { const int kb = r / 64, nb = r % 64; tr_item(a.in[IN_WOUT], D, D, 64 * kb, 32 * nb, Wt_out + (size_t)(32 * nb) * D, D, scr, F.lane); }
    }
    { const ConvJob J{a.in[IN_WG], a.in[IN_WU], a.in[IN_WD], (bf16*)(F.ws + WS_WGU), (bf16*)(F.ws + WS_WD)};
      for (int it = 2 * gw; it < 98304; it += 2 * NGW) k8_convert(J, it, 2, F.lane); }
    v4u* z = (v4u*)(Wt_in + (size_t)5664 * D); const int nz = 224 * D * 2 / 16;
    for (int i = F.bid * NTHR + F.tid; i < nz; i += F.G * NTHR) z[i] = (v4u){0u, 0u, 0u, 0u};
}

__device__ __forceinline__ void norm_rows(const Frame& F, const float* X, const float* nw, const float* sc, const float* sh, bf16* H) {
    f32x4 av[8], sv[8];
#pragma unroll
    for (int j = 0; j < 8; ++j) { const int k = 4 * F.lane + 256 * j; const f32x4 w = *(const f32x4*)(nw + k), s = *(const f32x4*)(sc + k); av[j] = w * (s + 1.f); sv[j] = *(const f32x4*)(sh + k); }
    const int gw = F.bid * NWAVES + F.wave, NGW = F.G * NWAVES;
    f32x4 nx[8];
    if (gw < T) {
#pragma unroll
        for (int j = 0; j < 8; ++j) nx[j] = ((const f32x4*)(X + (size_t)gw * D) + F.lane)[64 * j]; }
    for (int row = gw; row < T; row += NGW) {
        f32x4 v[8]; float s = 0.f;
#pragma unroll
        for (int j = 0; j < 8; ++j) { v[j] = nx[j]; s += (v[j].x * v[j].x + v[j].y * v[j].y) + (v[j].z * v[j].z + v[j].w * v[j].w); }
        if (row + NGW < T) {
#pragma unroll
            for (int j = 0; j < 8; ++j) nx[j] = ((const f32x4*)(X + (size_t)(row + NGW) * D) + F.lane)[64 * j]; }
        const float rstd = 1.f / sqrtf(wave_sum(s) * (1.f / D) + EPS);
        v2u* o = (v2u*)(H + (size_t)row * D) + F.lane;
#pragma unroll
        for (int j = 0; j < 8; ++j) { const f32x4 h = v[j] * rstd * av[j] + sv[j]; v2u w; w.x = pk2(h.x, h.y); w.y = pk2(h.z, h.w); o[64 * j] = w; }
    }
}
__device__ __forceinline__ void p1_router_prep(const Frame& F, const Args& a) {
    const float* mod = (const float*)(F.ws + WS_MOD); const float* sh2 = mod + 3 * D; const float* sc2 = mod + 4 * D;
    float* w2t = (float*)(F.ws + WS_W2T); float* bias2 = (float*)(F.ws + WS_BIAS2);
    const float* wrg = a.in[IN_WRG]; const float* wre = a.in[IN_WRE]; const float* n2w = a.in[IN_N2W];
    for (int i = F.bid * NTHR + F.tid; i < 48 * D; i += F.G * NTHR) {
        const int c = i / D, k = i % D; float v = 0.f;
        if (c < 36) { const float w = c < 4 ? wrg[k * 4 + c] : wre[k * 32 + (c - 4)]; v = w * n2w[k] * (1.f + sc2[k]); }
        w2t[i] = v;
    }
    if (F.bid == 0) {
        for (int c = F.wave; c < 48; c += NWAVES) { float s = 0.f;
            if (c < 36) { for (int k = F.lane; k < D; k += 64) { const float w = c < 4 ? wrg[k * 4 + c] : wre[k * 32 + (c - 4)]; s += sh2[k] * w; } s = wave_sum(s); s += c < 4 ? a.in[IN_BRG][c] : a.in[IN_BRE][c - 4]; }
            if (F.lane == 0) bias2[c] = s; }
    }
}

typedef short bf16x8 __attribute__((ext_vector_type(8)));
__device__ __forceinline__ f32x4 mma16(bf16x8 a, bf16x8 b, f32x4 c) { return __builtin_amdgcn_mfma_f32_16x16x32_bf16(a, b, c, 0, 0, 0); }

template <int MODE>
__device__ __forceinline__ void conv4_pair(const Frame& F, const Args& a, int c, int pp) {
    const int t0 = c * 64;
    const bf16* U = (const bf16*)(F.ws + WS_U);
    const float* cw = a.in[IN_SCONVW]; const float* cb = a.in[IN_SCONVB];
    float wa[4], wb[4];
#pragma unroll
    for (int j = 0; j < 4; ++j) { wa[j] = cw[j * 1536 + 2 * pp]; wb[j] = cw[j * 1536 + 2 * pp + 1]; }
    const float bia = cb[2 * pp], bib = cb[2 * pp + 1];
    float p3a = 0.f, p3b = 0.f, p2a = 0.f, p2b = 0.f, p1a = 0.f, p1b = 0.f;
    if (c > 0) {
        const unsigned u3 = ((const unsigned*)(U + (size_t)(t0 - 3) * NU + 4096))[pp], u2 = ((const unsigned*)(U + (size_t)(t0 - 2) * NU + 4096))[pp], u1 = ((const unsigned*)(U + (size_t)(t0 - 1) * NU + 4096))[pp];
        p3a = bflo(u3); p3b = bfhi(u3); p2a = bflo(u2); p2b = bfhi(u2); p1a = bflo(u1); p1b = bfhi(u1);
    }
    bf16* xsT = (bf16*)(F.ws + WS_XS); bf16* Bm = (bf16*)(F.ws + WS_BM); bf16* Cm = (bf16*)(F.ws + WS_CM); bf16* BmT = (bf16*)(F.ws + WS_BMT);
    unsigned un[8];
#pragma unroll
    for (int i = 0; i < 8; ++i) un[i] = ((const unsigned*)(U + (size_t)(t0 + i) * NU + 4096))[pp];
#pragma unroll
    for (int tb = 0; tb < 8; ++tb) {
        unsigned uu[8];
#pragma unroll
        for (int i = 0; i < 8; ++i) uu[i] = un[i];
        if (tb < 7) {
#pragma unroll
            for (int i = 0; i < 8; ++i) un[i] = ((const unsigned*)(U + (size_t)(t0 + (tb + 1) * 8 + i) * NU + 4096))[pp]; }
        float ya[8], yb[8];
#pragma unroll
        for (int i = 0; i < 8; ++i) { const float ua = bflo(uu[i]), ub = bfhi(uu[i]);
            ya[i] = silu_f(wa[0] * p3a + wa[1] * p2a + wa[2] * p1a + wa[3] * ua + bia); yb[i] = silu_f(wb[0] * p3b + wb[1] * p2b + wb[2] * p1b + wb[3] * ub + bib);
            p3a = p2a; p3b = p2b; p2a = p1a; p2b = p1b; p1a = ua; p1b = ub; }
        if (MODE != 2) { v4u va, vb;
#pragma unroll
            for (int q = 0; q < 4; ++q) { va[q] = pk2(ya[2 * q], ya[2 * q + 1]); vb[q] = pk2(yb[2 * q], yb[2 * q + 1]); }
            if (MODE == 0) { bf16* o = xsT + ((size_t)c * 1024 + 2 * pp) * 64 + tb * 8; *(v4u*)o = va; *(v4u*)(o + 64) = vb; }
            else { bf16* o = BmT + ((size_t)c * 256 + 2 * (pp - 512)) * 64 + tb * 8; *(v4u*)o = va; *(v4u*)(o + 64) = vb; } }
        if (MODE == 1) {
#pragma unroll
            for (int i = 0; i < 8; ++i) ((unsigned*)(Bm + (size_t)(t0 + tb * 8 + i) * 256))[pp - 512] = pk2(ya[i], yb[i]); }
        if (MODE == 2) {
#pragma unroll
            for (int i = 0; i < 8; ++i) ((unsigned*)(Cm + (size_t)(t0 + tb * 8 + i) * 256))[pp - 640] = pk2(ya[i], yb[i]); }
    }
}

__device__ __forceinline__ void p3_chunk(const Frame& F, const Args& a, int c) {
    const int t0 = c * 64, tid = F.tid;
    const bf16* U = (const bf16*)(F.ws + WS_U); bf16* ymix = (bf16*)(F.ws + WS_YMIX);
    {
        const float* cw = a.in[IN_CONVW];
        const float w0a = cw[2 * tid], w0b = cw[2 * tid + 1], w1a = cw[1024 + 2 * tid], w1b = cw[1024 + 2 * tid + 1], w2a = cw[2048 + 2 * tid], w2b = cw[2048 + 2 * tid + 1];
        float p2a = 0.f, p2b = 0.f, p1a = 0.f, p1b = 0.f;
        if (c > 0) { const unsigned* u2 = (const unsigned*)(U + (size_t)(t0 - 2) * NU); const unsigned* u1 = (const unsigned*)(U + (size_t)(t0 - 1) * NU);
            const unsigned c2 = u2[512 + tid], v2 = u2[1024 + tid], c1 = u1[512 + tid], v1 = u1[1024 + tid];
            p2a = bflo(c2) * bflo(v2); p2b = bfhi(c2) * bfhi(v2); p1a = bflo(c1) * bflo(v1); p1b = bfhi(c1) * bfhi(v1); }
        unsigned nb_[8], nc_[8], nv_[8];
#pragma unroll
        for (int i = 0; i < 8; ++i) { const unsigned* ur = (const unsigned*)(U + (size_t)(t0 + i) * NU); nb_[i] = ur[tid]; nc_[i] = ur[512 + tid]; nv_[i] = ur[1024 + tid]; }
#pragma unroll
        for (int tb = 0; tb < 8; ++tb) {
            unsigned cb_[8], cc_[8], cv_[8];
#pragma unroll
            for (int i = 0; i < 8; ++i) { cb_[i] = nb_[i]; cc_[i] = nc_[i]; cv_[i] = nv_[i]; }
            if (tb < 7) {
#pragma unroll
                for (int i = 0; i < 8; ++i) { const unsigned* ur = (const unsigned*)(U + (size_t)(t0 + (tb + 1) * 8 + i) * NU); nb_[i] = ur[tid]; nc_[i] = ur[512 + tid]; nv_[i] = ur[1024 + tid]; } }
#pragma unroll
            for (int i = 0; i < 8; ++i) {
                const float cva = bflo(cc_[i]) * bflo(cv_[i]), cvb = bfhi(cc_[i]) * bfhi(cv_[i]);
                const float ya = bflo(cb_[i]) * (w0a * p2a + w1a * p1a + w2a * cva), yb = bfhi(cb_[i]) * (w0b * p2b + w1b * p1b + w2b * cvb);
                ((unsigned*)(ymix + (size_t)(t0 + tb * 8 + i) * D))[tid] = pk2(ya, yb);
                p2a = p1a; p2b = p1b; p1a = cva; p1b = cvb;
            }
        }
    }
    conv4_pair<0>(F, a, c, tid);
    if (tid < 128) conv4_pair<1>(F, a, c, tid + 512); else if (tid < 256) conv4_pair<2>(F, a, c, tid + 512);
    float* dtT = (float*)(F.ws + WS_DT); float* acsT = (float*)(F.ws + WS_ACS); const float* udt = (const float*)(F.ws + WS_UDT);
#pragma unroll
    for (int hi = 0; hi < 2; ++hi) {
        const int h = F.wave + 8 * hi; const float bias = a.in[IN_DTB][h], A = -expf(a.in[IN_ALOG][h]);
        const float x = udt[(size_t)(t0 + F.lane) * 16 + h] + bias; const float dt = fmaxf(x, 0.f) + log1pf(expf(-fabsf(x)));
        float cs = A * dt;
#pragma unroll
        for (int o = 1; o < 64; o <<= 1) { const float v = __shfl_up(cs, o); cs += (F.lane >= o) ? v : 0.f; }
        dtT[((size_t)c * 16 + h) * 64 + F.lane] = dt; acsT[((size_t)c * 16 + h) * 64 + F.lane] = cs;
    }
    asm volatile("s_waitcnt vmcnt(0)" ::: "memory");
    __syncthreads();
    const bf16* xsT = (const bf16*)(F.ws + WS_XS); const bf16* BmT = (const bf16*)(F.ws + WS_BMT); bf16* st = (bf16*)(F.ws + WS_ST);
    const int fr = F.lane & 15, fq = F.lane >> 4;
#pragma unroll 1
    for (int hi = 0; hi < 2; ++hi) {
        const int h = F.wave + 8 * hi, g = h >> 3;
        const float* dT = dtT + ((size_t)c * 16 + h) * 64; const float* aT = acsT + ((size_t)c * 16 + h) * 64; const float a63 = aT[63];
        bf16x8 xb[4][2];
#pragma unroll
        for (int ks = 0; ks < 2; ++ks) {
            const f32x4 d0 = *(const f32x4*)(dT + 32 * ks + 8 * fq), d1 = *(const f32x4*)(dT + 32 * ks + 8 * fq + 4), a0 = *(const f32x4*)(aT + 32 * ks + 8 * fq), a1 = *(const f32x4*)(aT + 32 * ks + 8 * fq + 4);
            float w[8];
#pragma unroll
            for (int j = 0; j < 4; ++j) { w[j] = d0[j] * __expf(a63 - a0[j]); w[4 + j] = d1[j] * __expf(a63 - a1[j]); }
#pragma unroll
            for (int nb = 0; nb < 4; ++nb) { const v4u raw = *(const v4u*)(xsT + ((size_t)c * 1024 + h * 64 + nb * 16 + fr) * 64 + 32 * ks + 8 * fq); v4u sc;
#pragma unroll
                for (int q = 0; q < 4; ++q) sc[q] = pk2(bflo(raw[q]) * w[2 * q], bfhi(raw[q]) * w[2 * q + 1]);
                xb[nb][ks] = __builtin_bit_cast(bf16x8, sc); }
        }
#pragma unroll 1
        for (int half = 0; half < 2; ++half) {
            f32x4 acc[4][4];
#pragma unroll
            for (int mb = 0; mb < 4; ++mb)
#pragma unroll
                for (int nb = 0; nb < 4; ++nb) acc[mb][nb] = (f32x4){0.f, 0.f, 0.f, 0.f};
#pragma unroll
            for (int ks = 0; ks < 2; ++ks)
#pragma unroll
                for (int mb = 0; mb < 4; ++mb) { const bf16x8 av = *(const bf16x8*)(BmT + ((size_t)c * 256 + g * 128 + half * 64 + mb * 16 + fr) * 64 + 32 * ks + 8 * fq);
#pragma unroll
                    for (int nb = 0; nb < 4; ++nb) acc[mb][nb] = mma16(av, xb[nb][ks], acc[mb][nb]); }
#pragma unroll
            for (int mb = 0; mb < 4; ++mb)
#pragma unroll
                for (int nb = 0; nb < 4; ++nb) { v2u w; w.x = pk2(acc[mb][nb][0], acc[mb][nb][1]); w.y = pk2(acc[mb][nb][2], acc[mb][nb][3]);
                    *(v2u*)(st + (((size_t)c * 16 + h) * 64 + nb * 16 + fr) * 128 + half * 64 + mb * 16 + 4 * fq) = w; }
        }
    }
}

__device__ __forceinline__ void p_scan(const Frame& F) {
    bf16* st = (bf16*)(F.ws + WS_ST); const float* acsT = (const float*)(F.ws + WS_ACS);
    for (int e = F.bid * NTHR + F.tid; e < 16 * 64 * 128; e += F.G * NTHR) {
        const int head = e >> 13; float h = 0.f;
#pragma unroll 1
        for (int cb = 0; cb < NCHUNK; cb += 32) {
            unsigned short sv[32]; float dv[32];
#pragma unroll
            for (int i = 0; i < 32; ++i) { sv[i] = st[(size_t)(cb + i) * 131072 + e]; dv[i] = acsT[((size_t)(cb + i) * 16 + head) * 64 + 63]; }
#pragma unroll
            for (int i = 0; i < 32; ++i) { st[(size_t)(cb + i) * 131072 + e] = (bf16)(pk2(h, 0.f) & 0xffffu); h = h * __expf(dv[i]) + bflo((unsigned)sv[i]); }
        }
    }
}

__device__ __forceinline__ void p4_unit(const Frame& F, const Args& a, int c, int g) {
    const int t0 = c * 64, hh = F.wave, h = g * 8 + hh, fr = F.lane & 15, fq = F.lane >> 4;
    const bf16* U = (const bf16*)(F.ws + WS_U); bf16* ymix = (bf16*)(F.ws + WS_YMIX);
    const bf16* xsT = (const bf16*)(F.ws + WS_XS); const bf16* Bm = (const bf16*)(F.ws + WS_BM); const bf16* Cm = (const bf16*)(F.ws + WS_CM);
    const float* dT = (const float*)(F.ws + WS_DT) + ((size_t)c * 16 + h) * 64; const float* aT = (const float*)(F.ws + WS_ACS) + ((size_t)c * 16 + h) * 64;
    const bf16* pv = (const bf16*)(F.ws + WS_ST) + ((size_t)c * 16 + h) * 64 * 128;
    LAS unsigned char* mbuf = F.lds + hh * 9216;
    LAS float* sred = (LAS float*)(F.lds + 73728);
    LAS float* srs = (LAS float*)(F.lds + 75776);
    float al[4];
#pragma unroll
    for (int nb = 0; nb < 4; ++nb) al[nb] = aT[nb * 16 + fr];
    bf16x8 cf[4][4];
#pragma unroll
    for (int nb = 0; nb < 4; ++nb)
#pragma unroll
        for (int ks = 0; ks < 4; ++ks) cf[nb][ks] = *(const bf16x8*)(Cm + (size_t)(t0 + nb * 16 + fr) * 256 + g * 128 + 32 * ks + 8 * fq);
    f32x4 acc[4][4];
#pragma unroll
    for (int mb = 0; mb < 4; ++mb)
#pragma unroll
        for (int nb = 0; nb < 4; ++nb) acc[mb][nb] = (f32x4){0.f, 0.f, 0.f, 0.f};
#pragma unroll
    for (int ks = 0; ks < 4; ++ks)
#pragma unroll
        for (int mb = 0; mb < 4; ++mb) { const bf16x8 bv = *(const bf16x8*)(Bm + (size_t)(t0 + mb * 16 + fr) * 256 + g * 128 + 32 * ks + 8 * fq);
#pragma unroll
            for (int nb = 0; nb < 4; ++nb) acc[mb][nb] = mma16(bv, cf[nb][ks], acc[mb][nb]); }
    {
        const float dsk = a.in[IN_DSKIP][h];
#pragma unroll
        for (int mb = 0; mb < 4; ++mb) { const f32x4 as = *(const f32x4*)(aT + mb * 16 + 4 * fq), ds = *(const f32x4*)(dT + mb * 16 + 4 * fq);
#pragma unroll
            for (int nb = 0; nb < 4; ++nb) { const int l = nb * 16 + fr; float m[4];
#pragma unroll
                for (int r = 0; r < 4; ++r) { const int s = mb * 16 + 4 * fq + r; const float v = acc[mb][nb][r] * __expf(al[nb] - as[r]) * ds[r]; m[r] = (s <= l) ? v : 0.f; m[r] += (s == l) ? dsk : 0.f; }
                v2u w; w.x = pk2(m[0], m[1]); w.y = pk2(m[2], m[3]);
                *(LAS v2u*)(mbuf + l * 144 + (mb * 16 + 4 * fq) * 2) = w; } }
    }
#pragma unroll
    for (int mb = 0; mb < 4; ++mb)
#pragma unroll
        for (int nb = 0; nb < 4; ++nb) acc[mb][nb] = (f32x4){0.f, 0.f, 0.f, 0.f};
#pragma unroll
    for (int ks = 0; ks < 4; ++ks)
#pragma unroll
        for (int mb = 0; mb < 4; ++mb) { const bf16x8 pvv = *(const bf16x8*)(pv + (size_t)(mb * 16 + fr) * 128 + 32 * ks + 8 * fq);
#pragma unroll
            for (int nb = 0; nb < 4; ++nb) acc[mb][nb] = mma16(pvv, cf[nb][ks], acc[mb][nb]); }
#pragma unroll
    for (int nb = 0; nb < 4; ++nb) { const float ea = __expf(al[nb]);
#pragma unroll
        for (int mb = 0; mb < 4; ++mb) acc[mb][nb] = acc[mb][nb] * ea; }
    LDS_WAIT();
#pragma unroll
    for (int ks = 0; ks < 2; ++ks) {
        bf16x8 mf[4];
#pragma unroll
        for (int nb = 0; nb < 4; ++nb) mf[nb] = *(const LAS bf16x8*)(mbuf + (nb * 16 + fr) * 144 + (32 * ks + 8 * fq) * 2);
#pragma unroll
        for (int mb = 0; mb < 4; ++mb) { const bf16x8 xv = *(const bf16x8*)(xsT + ((size_t)c * 1024 + h * 64 + mb * 16 + fr) * 64 + 32 * ks + 8 * fq);
#pragma unroll
            for (int nb = 0; nb < 4; ++nb) acc[mb][nb] = mma16(xv, mf[nb], acc[mb][nb]); }
    }
    float ss[4] = {0.f, 0.f, 0.f, 0.f};
#pragma unroll
    for (int nb = 0; nb < 4; ++nb)
#pragma unroll
        for (int mb = 0; mb < 4; ++mb) { const v2u zv = *(const v2u*)(U + (size_t)(t0 + nb * 16 + fr) * NU + 3072 + h * 64 + mb * 16 + 4 * fq);
            f32x4 y = acc[mb][nb]; y[0] *= silu_f(bflo(zv.x)); y[1] *= silu_f(bfhi(zv.x)); y[2] *= silu_f(bflo(zv.y)); y[3] *= silu_f(bfhi(zv.y));
            acc[mb][nb] = y; ss[nb] += (y[0] * y[0] + y[1] * y[1]) + (y[2] * y[2] + y[3] * y[3]); }
#pragma unroll
    for (int nb = 0; nb < 4; ++nb) { float s = ss[nb]; s += __shfl_xor(s, 16); s += __shfl_xor(s, 32); if (fq == 0) sred[hh * 64 + nb * 16 + fr] = s; }
    __syncthreads();
    if (F.tid < 64) { float s = 0.f;
#pragma unroll
        for (int w = 0; w < 8; ++w) s += sred[w * 64 + F.tid];
        srs[F.tid] = 1.f / sqrtf(s * (1.f / 512.f) + EPS); }
    __syncthreads();
    {
        const float* nw = a.in[IN_SNW] + h * 64;
#pragma unroll
        for (int nb = 0; nb < 4; ++nb) { const float r = srs[nb * 16 + fr];
#pragma unroll
            for (int mb = 0; mb < 4; ++mb) { const f32x4 n4 = *(const f32x4*)(nw + mb * 16 + 4 * fq); const f32x4 y = acc[mb][nb] * r * n4;
                v2u w; w.x = pk2(y[0], y[1]); w.y = pk2(y[2], y[3]);
                *(v2u*)(ymix + (size_t)(t0 + nb * 16 + fr) * D + 1024 + h * 64 + mb * 16 + 4 * fq) = w; } }
    }
    __syncthreads();
}

__device__ __forceinline__ void p6_unit(const Frame& F, const Args& a, int u) {
    const int t0 = u * 64, tid = F.tid, lane = F.lane, wave = F.wave;
    const float* X1 = a.out; const float* w2t = (const float*)(F.ws + WS_W2T); const float* bias2 = (const float*)(F.ws + WS_BIAS2);
    const float* mod = (const float*)(F.ws + WS_MOD);
    LAS float* spart = (LAS float*)F.lds;
    LAS float* sssq = (LAS float*)(F.lds + 98304);
    LAS float* srstd = (LAS float*)(F.lds + 100352);
    LAS int* seid = (LAS int*)(F.lds + 100608);
    LAS int* shist = (LAS int*)(F.lds + 101120);
    const int r16 = lane & 15, q = lane >> 4, k0 = wave * 256 + 4 * q;
    f32x4 acc[4][3];
#pragma unroll
    for (int rb = 0; rb < 4; ++rb)
#pragma unroll
        for (int cb = 0; cb < 3; ++cb) acc[rb][cb] = (f32x4){0.f, 0.f, 0.f, 0.f};
    float ssq[4] = {0.f, 0.f, 0.f, 0.f};
    const float* xrow = X1 + (size_t)(t0 + r16) * D + k0;
    const float* wrow = w2t + (size_t)r16 * D + k0;
#pragma unroll 2
    for (int s = 0; s < 16; ++s) {
        f32x4 av[4], bv[3];
#pragma unroll
        for (int rb = 0; rb < 4; ++rb) av[rb] = *(const f32x4*)(xrow + (size_t)rb * 16 * D + 16 * s);
#pragma unroll
        for (int cb = 0; cb < 3; ++cb) bv[cb] = *(const f32x4*)(wrow + (size_t)cb * 16 * D + 16 * s);
#pragma unroll
        for (int rb = 0; rb < 4; ++rb) ssq[rb] += (av[rb].x * av[rb].x + av[rb].y * av[rb].y) + (av[rb].z * av[rb].z + av[rb].w * av[rb].w);
#pragma unroll
        for (int e = 0; e < 4; ++e)
#pragma unroll
            for (int rb = 0; rb < 4; ++rb)
#pragma unroll
                for (int cb = 0; cb < 3; ++cb) acc[rb][cb] = __builtin_amdgcn_mfma_f32_16x16x4f32(av[rb][e], bv[cb][e], acc[rb][cb], 0, 0, 0);
    }
#pragma unroll
    for (int rb = 0; rb < 4; ++rb)
#pragma unroll
        for (int cb = 0; cb < 3; ++cb)
#pragma unroll
            for (int r = 0; r < 4; ++r) spart[(wave * 64 + rb * 16 + 4 * q + r) * 48 + cb * 16 + r16] = acc[rb][cb][r];
#pragma unroll
    for (int rb = 0; rb < 4; ++rb) { float s = ssq[rb]; s += __shfl_xor(s, 16); s += __shfl_xor(s, 32); if (q == 0) sssq[wave * 64 + rb * 16 + r16] = s; }
    if (tid < 32) shist[tid] = 0;
    __syncthreads();
    LAS float* slog = (LAS float*)(F.lds + 102400);
    for (int i = tid; i < 64 * 48; i += NTHR) { float v = 0.f;
#pragma unroll
        for (int w = 0; w < 8; ++w) v += spart[w * 64 * 48 + i];
        slog[i] = v; }
    if (tid < 64) { float s = 0.f;
#pragma unroll
        for (int w = 0; w < 8; ++w) s += sssq[w * 64 + tid];
        srstd[tid] = 1.f / sqrtf(s * (1.f / D) + EPS); }
    __syncthreads();
    if (tid < 64) {
        const float rstd = srstd[tid];
        float lg[36];
#pragma unroll
        for (int c = 0; c < 36; ++c) lg[c] = slog[tid * 48 + c] * rstd + bias2[c];
        int gi = 0; float gm = lg[0];
#pragma unroll
        for (int c = 1; c < 4; ++c) if (lg[c] > gm) { gm = lg[c]; gi = c; }
        float gs = 0.f;
#pragma unroll
        for (int c = 0; c < 4; ++c) gs += expf(lg[c] - gm);
        const float grp_p = 1.f / gs;
        float le[8];
#pragma unroll
        for (int j = 0; j < 8; ++j) { float v = lg[4 + j];
#pragma unroll
            for (int g2 = 1; g2 < 4; ++g2) v = (gi == g2) ? lg[4 + g2 * 8 + j] : v;
            le[j] = v; }
        int j1 = 0; float m1 = le[0];
#pragma unroll
        for (int j = 1; j < 8; ++j) if (le[j] > m1) { m1 = le[j]; j1 = j; }
        int j2 = -1; float m2 = -3.0e38f;
#pragma unroll
        for (int j = 0; j < 8; ++j) if (j != j1 && le[j] > m2) { m2 = le[j]; j2 = j; }
        const float e2 = expf(m2 - m1), w1 = grp_p / (1.f + e2), w2 = grp_p * e2 / (1.f + e2);
        const int ex1 = gi * 8 + j1, ex2 = gi * 8 + j2, t = t0 + tid;
        ((int*)(F.ws + WS_EID))[2 * t] = ex1; ((int*)(F.ws + WS_EID))[2 * t + 1] = ex2;
        ((float*)(F.ws + WS_EW))[2 * t] = w1; ((float*)(F.ws + WS_EW))[2 * t + 1] = w2;
        seid[2 * tid] = ex1; seid[2 * tid + 1] = ex2;
        __hip_atomic_fetch_add(&shist[ex1], 1, __ATOMIC_RELAXED, __HIP_MEMORY_SCOPE_WORKGROUP); __hip_atomic_fetch_add(&shist[ex2], 1, __ATOMIC_RELAXED, __HIP_MEMORY_SCOPE_WORKGROUP);
    }
    __syncthreads();
    if (tid < 32) ((int*)(F.ws + WS_BLKCNT))[u * 32 + tid] = shist[tid];
    if (tid < 128) { const int e = seid[tid]; int r = 0; for (int j = 0; j < tid; ++j) r += (seid[j] == e) ? 1 : 0; ((int*)(F.ws + WS_RANK))[2 * t0 + tid] = r; }
    {
        const float* n2w = a.in[IN_N2W]; const float* sh2 = mod + 3 * D; const float* sc2 = mod + 4 * D; bf16* H = (bf16*)(F.ws + WS_H);
        f32x4 av2[8], bv2[8];
#pragma unroll
        for (int j = 0; j < 8; ++j) { const int k = 4 * lane + 256 * j; const f32x4 w = *(const f32x4*)(n2w + k), s = *(const f32x4*)(sc2 + k); av2[j] = w * (s + 1.f); bv2[j] = *(const f32x4*)(sh2 + k); }
#pragma unroll 1
        for (int i = 0; i < 8; i += 2) {
            f32x4 xv[2][8];
#pragma unroll
            for (int u2 = 0; u2 < 2; ++u2)
#pragma unroll
                for (int j = 0; j < 8; ++j) xv[u2][j] = ((const f32x4*)(X1 + (size_t)(t0 + wave * 8 + i + u2) * D) + lane)[64 * j];
#pragma unroll
            for (int u2 = 0; u2 < 2; ++u2) { const int tok = wave * 8 + i + u2; const float rstd = srstd[tok]; v2u* o = (v2u*)(H + (size_t)(t0 + tok) * D) + lane;
#pragma unroll
                for (int j = 0; j < 8; ++j) { const f32x4 hv = xv[u2][j] * rstd * av2[j] + bv2[j]; v2u pw; pw.x = pk2(hv.x, hv.y); pw.y = pk2(hv.z, hv.w); o[64 * j] = pw; } }
        }
    }
    __syncthreads();
}

__device__ __forceinline__ void p7_unit(const Frame& F, int u) {
    const int t0 = u * 64, tid = F.tid;
    const int* blkcnt = (const int*)(F.ws + WS_BLKCNT); int* slot = (int*)(F.ws + WS_SLOT); const int* eid = (const int*)(F.ws + WS_EID);
    LAS int* stot = (LAS int*)F.lds;
    LAS int* sbef = (LAS int*)(F.lds + 128);
    LAS int* sbase = (LAS int*)(F.lds + 256);
    LAS int* sslot = (LAS int*)(F.lds + 512);
    LAS int* scnt = (LAS int*)(F.lds + 1024);
    for (int i = tid; i < NCHUNK * 32 / 4; i += NTHR) *(LAS v4u*)(scnt + 4 * i) = *(const v4u*)(blkcnt + 4 * i);
    __syncthreads();
    if (tid < 32) { int tot = 0, bef = 0;
#pragma unroll 8
        for (int b = 0; b < NCHUNK; ++b) { const int v = scnt[b * 32 + tid]; tot += v; bef += (b < u) ? v : 0; } stot[tid] = tot; sbef[tid] = bef; }
    __syncthreads();
    if (tid == 0) { int ps = 0; for (int e = 0; e < 32; ++e) { sbase[e] = ps + sbef[e];
            if (u == 0) { int* tile_e = (int*)(F.ws + WS_TILE); for (int i = ps >> 8; i < ((ps + ((stot[e] + 255) & ~255)) >> 8); ++i) tile_e[i] = e; }
            ps += (stot[e] + 255) & ~255; }
        if (u == 0) ((int*)(F.ws + WS_TILE))[192] = ps >> 8; }
    __syncthreads();
    if (tid < 128) { const int s = sbase[eid[2 * t0 + tid]] + ((const int*)(F.ws + WS_RANK))[2 * t0 + tid]; sslot[tid] = s; slot[2 * t0 + tid] = s; }
    __syncthreads();
    const bf16* H = (const bf16*)(F.ws + WS_H); bf16* hs = (bf16*)(F.ws + WS_U);
    for (int i = 0; i < 16; ++i) { const int a = F.wave * 16 + i, s = sslot[a]; const v4u* src = (const v4u*)(H + (size_t)(t0 + (a >> 1)) * D) + F.lane; v4u* dst = (v4u*)(hs + (size_t)s * D) + F.lane;
#pragma unroll
        for (int j = 0; j < 4; ++j) dst[64 * j] = src[64 * j]; }
    __syncthreads();
}

__device__ __forceinline__ void p10_rows(const Frame& F, const Args& a) {
    const float* mod = (const float*)(F.ws + WS_MOD); const float* g2 = mod + 5 * D; const float* fw = a.in[IN_FNW];
    const int* slot = (const int*)(F.ws + WS_SLOT); const float* ew = (const float*)(F.ws + WS_EW); const bf16* yb = (const bf16*)(F.ws + WS_YB);
    float dbg = 0.f;
#if defined(MK_DEBUG_CHECK)
    dbg = __builtin_bit_cast(float, __hip_atomic_load((unsigned*)(F.ws + WS_CTL) + CW_DBG, __ATOMIC_RELAXED, __HIP_MEMORY_SCOPE_AGENT));
#endif
    const int gw = F.bid * NWAVES + F.wave, NGW = F.G * NWAVES;
    f32x4 gv[8], fv[8];
#pragma unroll
    for (int j = 0; j < 8; ++j) { const int k = 4 * F.lane + 256 * j; gv[j] = *(const f32x4*)(g2 + k); fv[j] = *(const f32x4*)(fw + k); }
    f32x4 nx[8]; v2u ny0[8], ny1[8]; float nw0 = 0.f, nw1 = 0.f;
#define P10_LOAD(row_) do { const int s0_ = slot[2 * (row_)], s1_ = slot[2 * (row_) + 1]; nw0 = ew[2 * (row_)]; nw1 = ew[2 * (row_) + 1]; \
        const float* xr_ = a.out + (size_t)(row_) * D; const v2u* y0_ = (const v2u*)(yb + (size_t)s0_ * D) + F.lane; const v2u* y1_ = (const v2u*)(yb + (size_t)s1_ * D) + F.lane; \
        _Pragma("unroll") for (int j = 0; j < 8; ++j) { nx[j] = *(const f32x4*)(xr_ + 4 * F.lane + 256 * j); ny0[j] = y0_[64 * j]; ny1[j] = y1_[64 * j]; } } while (0)
    if (gw < T) P10_LOAD(gw);
    for (int row = gw; row < T; row += NGW) {
        f32x4 v[8]; float s = 0.f; const float w0 = nw0, w1 = nw1;
#pragma unroll
        for (int j = 0; j < 8; ++j) { const v2u a0 = ny0[j], a1 = ny1[j];
            f32x4 m; m.x = w0 * bflo(a0.x) + w1 * bflo(a1.x); m.y = w0 * bfhi(a0.x) + w1 * bfhi(a1.x); m.z = w0 * bflo(a0.y) + w1 * bflo(a1.y); m.w = w0 * bfhi(a0.y) + w1 * bfhi(a1.y);
            v[j] = nx[j] + gv[j] * m; s += (v[j].x * v[j].x + v[j].y * v[j].y) + (v[j].z * v[j].z + v[j].w * v[j].w); }
        if (row + NGW < T) P10_LOAD(row + NGW);
        const float rstd = (1.f + dbg) / sqrtf(wave_sum(s) * (1.f / D) + EPS);
        float* xr = a.out + (size_t)row * D;
#pragma unroll
        for (int j = 0; j < 8; ++j) *(f32x4*)(xr + 4 * F.lane + 256 * j) = v[j] * rstd * fv[j];
    }
#undef P10_LOAD
}

constexpr int NPHASES = 12;
__global__ void __launch_bounds__(NTHR, 2) mk_fwd(Args args) {
    extern __shared__ __attribute__((aligned(16))) unsigned char lds_raw[];
    Frame F;
    F.lds = (LAS unsigned char*)lds_raw;
    F.tid = threadIdx.x; F.lane = F.tid & 63; F.wave = __builtin_amdgcn_readfirstlane(F.tid >> 6);
    F.G = gridDim.x; F.bid = blockIdx.x; F.vcu = (F.G % 8 == 0) ? (F.bid % 8) * (F.G / 8) + F.bid / 8 : F.bid;
    F.ws = args.ws;
    volatile LAS unsigned* MISC = (volatile LAS unsigned*)(F.lds + MISC_OFF);
    if (F.tid < 16) MISC[F.tid] = 0u;
    __syncthreads();
    const int lo = args.ph_lo, hi = args.ph_hi;
    XcdBarrier bar; bar.bar = (unsigned*)(F.ws + WS_CTL) + CW_BAR + args.li * XCD_BAR_WORDS; bar.x = 0; bar.st = nullptr;
    if (hi - lo > 1) bar = xcd_barrier_post((unsigned*)(F.ws + WS_CTL) + CW_BAR + args.li * XCD_BAR_WORDS, MISC + 8);
#define IN(k) (lo <= (k) && (k) < hi)
#define SEAM(k) do { if (IN(k) && IN((k) + 1)) xcd_barrier(bar); } while (0)
    float* mod = (float*)(F.ws + WS_MOD);

    if (IN(0)) { p0_ada(F, args.in[IN_C], args.in[IN_WADA], args.in[IN_BADA], mod); p0_convert(F, args); }
    SEAM(0);
    if (IN(1)) { norm_rows(F, args.in[IN_X], args.in[IN_N1W], mod + D, mod, (bf16*)(F.ws + WS_H)); p1_router_prep(F, args); }
    SEAM(1);
    if (IN(2)) {
        pg8::Gemm g{(const pg8::bf16_t*)(F.ws + WS_H), (const pg8::bf16_t*)(F.ws + WS_WIN), T, N_IN_PAD, D, 0}; ConvOrder S; S.init(T, N_IN_PAD, F.G, F.bid);
        S.J = ConvJob{args.in[IN_WG], args.in[IN_WU], args.in[IN_WD], (bf16*)(F.ws + WS_WGU), (bf16*)(F.ws + WS_WD)};
        const int nmy = (S.nwg - F.bid + F.G - 1) / F.G, gwv = F.bid * NWAVES + F.wave, per = 65536 / (F.G * NWAVES);
        S.pos = -2; S.it0 = gwv * per; S.nit = 0; (void)nmy;
        pg8::EpiU E{(pg8::bf16_t*)(F.ws + WS_U), (float*)(F.ws + WS_UDT)};
        pg8::gemm_phase<pg8::EpiU, ConvOrder, true, true>(F.lds, g, S, E);
    }
    SEAM(2);
    if (IN(3)) { for (int c = F.bid; c < NCHUNK; c += F.G) p3_chunk(F, args, c); }
    SEAM(3);
    if (IN(4)) p_scan(F);
    SEAM(4);
    if (IN(5)) { for (int u = F.bid; u < 2 * NCHUNK; u += F.G) p4_unit(F, args, u >> 1, u & 1); }
    SEAM(5);
    if (IN(6)) {
        pg8::Gemm g{(const pg8::bf16_t*)(F.ws + WS_YMIX), (const pg8::bf16_t*)(F.ws + WS_WOUT), T, D, D, 0}; ConvOrder S; S.init(T, D, F.G, F.bid);
        S.J = ConvJob{args.in[IN_WG], args.in[IN_WU], args.in[IN_WD], (bf16*)(F.ws + WS_WGU), (bf16*)(F.ws + WS_WD)};
        const int nmy = (S.nwg - F.bid + F.G - 1) / F.G, gwv = F.bid * NWAVES + F.wave, per = 32768 / (F.G * NWAVES);
        S.pos = -2; S.it0 = 65536 + gwv * per; S.nit = 0; (void)nmy;
        pg8::EpiX1 E{args.in[IN_X], args.out, mod + 2 * D};
        pg8::gemm_phase<pg8::EpiX1, ConvOrder, true, true>(F.lds, g, S, E);
    }
    SEAM(6);
    if (IN(7)) { for (int u = F.bid; u < NCHUNK; u += F.G) p6_unit(F, args, u); }
    SEAM(7);
    if (IN(8)) { for (int u = F.bid; u < NCHUNK; u += F.G) p7_unit(F, u); }
    SEAM(8);
    if (IN(9)) {
        const int ntiles = __builtin_amdgcn_readfirstlane(__hip_atomic_load((int*)(F.ws + WS_TILE) + 192, __ATOMIC_RELAXED, __HIP_MEMORY_SCOPE_AGENT));
        pg8::Gemm g{(const pg8::bf16_t*)(F.ws + WS_U), (const pg8::bf16_t*)(F.ws + WS_WGU), ntiles * 256, 2048, D, (size_t)2048 * D * 2};
        pg8::MoeOrder S{(const int*)(F.ws + WS_TILE), ntiles * 8, 8, F.G, F.vcu};
        pg8::EpiHid E{(pg8::bf16_t*)(F.ws + WS_YMIX)};
        pg8::gemm_phase<pg8::EpiHid, pg8::MoeOrder, true, true, true>(F.lds, g, S, E);
    }
    SEAM(9);
    if (IN(10)) {
        const int ntiles = __builtin_amdgcn_readfirstlane(__hip_atomic_load((int*)(F.ws + WS_TILE) + 192, __ATOMIC_RELAXED, __HIP_MEMORY_SCOPE_AGENT));
        pg8::Gemm g{(const pg8::bf16_t*)(F.ws + WS_YMIX), (const pg8::bf16_t*)(F.ws + WS_WD), ntiles * 256, 2048, FF, (size_t)2048 * FF * 2};
        pg8::MoeOrder S{(const int*)(F.ws + WS_TILE), ntiles * 8, 8, F.G, F.vcu};
        pg8::EpiY E{(pg8::bf16_t*)(F.ws + WS_YB)};
        pg8::gemm_phase<pg8::EpiY, pg8::MoeOrder, true, true, true>(F.lds, g, S, E);
    }
    SEAM(10);
    if (IN(11)) p10_rows(F, args);
#undef IN
#undef SEAM
}

extern "C" void kernel_launch(void* const* d_in, const int* in_sizes, int n_in, void* d_out, int out_size, void* d_ws, size_t ws_size, hipStream_t stream) {
    static int grid = 0;
    if (grid == 0) {
        if (n_in != N_INPUTS || in_sizes[0] != T * D || out_size != T * D || ws_size < WS_END) { fprintf(stderr, "kernel_launch: unexpected shapes (n_in %d, in0 %d, out %d, ws %zu < %zu); nothing launched\n", n_in, n_in > 0 ? in_sizes[0] : -1, out_size, ws_size, (size_t)WS_END); grid = -1; return; }
        int dev = 0, cus = 0, per_cu = 0;
        if (hipGetDevice(&dev) != hipSuccess || hipDeviceGetAttribute(&cus, hipDeviceAttributeMultiprocessorCount, dev) != hipSuccess) { fprintf(stderr, "kernel_launch: device query failed\n"); grid = -1; return; }
        if (hipFuncSetAttribute((const void*)mk_fwd, hipFuncAttributeMaxDynamicSharedMemorySize, LDS_BYTES) != hipSuccess) { fprintf(stderr, "kernel_launch: hipFuncSetAttribute failed\n"); grid = -1; return; }
        if (hipOccupancyMaxActiveBlocksPerMultiprocessor(&per_cu, (const void*)mk_fwd, NTHR, LDS_BYTES) != hipSuccess || per_cu < 1) fprintf(stderr, "kernel_launch: note: occupancy query reports %d workgroups per CU\n", per_cu);
        (void)hipGetLastError();
        grid = cus;
    }
    if (grid < 0) return;
    if (hipMemsetAsync((char*)d_ws + WS_CTL, 0, CTL_ZERO_BYTES, stream) != hipSuccess) { fprintf(stderr, "kernel_launch: memset failed\n"); return; }
    Args a{};
    for (int i = 0; i < N_INPUTS; ++i) a.in[i] = (const float*)d_in[i];
    a.out = (float*)d_out; a.ws = (unsigned char*)d_ws;
#if defined(MK_PROBE) && MK_PROBE == 1
    static const int cuts[][2] = {{0, 1}, {0, 12}};
#elif defined(MK_PROBE) && MK_PROBE == 2
    static const int cuts[][2] = {{0, 3}, {1, 12}};
#elif defined(MK_PROBE) && MK_PROBE == 3
    static const int cuts[][2] = {{0, 6}, {3, 12}};
#elif defined(MK_PROBE) && MK_PROBE == 4
    static const int cuts[][2] = {{0, 8}, {6, 12}};
#elif defined(MK_PROBE) && MK_PROBE == 5
    static const int cuts[][2] = {{0, 11}, {9, 12}};
#elif defined(MK_PROBE) && MK_PROBE == 6
    static const int cuts[][2] = {{0, 4}, {3, 12}};
#elif defined(MK_PROBE) && MK_PROBE == 7
    static const int cuts[][2] = {{0, 6}, {5, 12}};
#elif defined(MK_PROBE) && MK_PROBE == 8
    static const int cuts[][2] = {{0, 8}, {7, 12}};
#elif defined(MK_PROBE) && MK_PROBE == 9
    static const int cuts[][2] = {{0, 7}, {6, 12}};
#elif defined(MK_PROBE) && MK_PROBE == 10
    static const int cuts[][2] = {{0, 9}, {8, 12}};
#elif defined(MK_PROBE) && MK_PROBE == 11
    static const int cuts[][2] = {{0, 5}, {12, 12}, {4, 12}};
#elif MK_N_LAUNCHES == 1
    static const int cuts[][2] = {{0, NPHASES}};
#else
    static const int cuts[][2] = {{0, 1}, {1, 2}, {2, 3}, {3, 4}, {4, 5}, {5, 6}, {6, 7}, {7, 8}, {8, 9}, {9, 10}, {10, 11}, {11, 12}};
#endif
    for (int li = 0; li < (int)(sizeof(cuts) / sizeof(cuts[0])); ++li) { a.ph_lo = cuts[li][0]; a.ph_hi = cuts[li][1]; a.li = li; hipLaunchKernelGGL(mk_fwd, dim3(grid), dim3(NTHR), LDS_BYTES, stream, a); }
    const hipError_t le = hipPeekAtLastError();
    if (le != hipSuccess) fprintf(stderr, "kernel_launch: launch failed: %s\n", hipGetErrorName(le));
}
```

```cpp
#include <hip/hip_runtime.h>
#include <cstdio>
#include <cstdint>

#ifndef MK_N_LAUNCHES
#define MK_N_LAUNCHES 1
#endif

namespace pg8 {
#define PG8_LAS __attribute__((address_space(3)))
typedef unsigned short bf16_t;
typedef short bf16x8 __attribute__((ext_vector_type(8)));
typedef float f32x4 __attribute__((ext_vector_type(4)));
typedef unsigned u32x4 __attribute__((ext_vector_type(4)));
constexpr int BM = 256, BK = 64, HALF = 128, HTB = HALF * BK * 2  , STAGE_BYTES = 8 * HTB, NXCD = 8, WGM = 8;

__host__ __device__ __forceinline__ int lds_byte(int r, int c) { const int st = (r >> 4) * 2 + (c >> 5), rr = r & 15, cc = c & 31, ob = rr * 64 + cc * 2; return st * 1024 + (ob ^ (((ob >> 9) & 1) << 5)); }
__host__ __device__ __forceinline__ void stage_rc(int b, int& R, int& C) { const int st = b / 1024, sb = b % 1024, swz = sb ^ (((sb >> 9) & 1) << 5); R = (st >> 1) * 16 + swz / 64; C = (st & 1) * 32 + (swz % 64) / 2; }
__host__ __device__ __forceinline__ int perm32(int rho) { const int n = rho >> 4, i = rho & 15; return 8 * (i >> 2) + 4 * n + (i & 3); }

struct Unit { int pm, pn, pb, pe; };
struct Gemm { const bf16_t* A; const bf16_t* Bt; int M, N, K; size_t estep; };

struct StaticOrder {
    int nM, nN, nwg, G, c;
    __host__ __device__ void init(int M, int N, int G_, int c_) { nM = M / BM; nN = N / BM; nwg = nM * nN; G = G_; c = c_; }
    __host__ __device__ bool next(int i, Unit& u) const {
        const long L = (long)i * G + c; if (L >= nwg) return false;
        int wgid = (int)L; { const int q = nwg / NXCD, r = nwg % NXCD, xcd = wgid % NXCD, off = wgid / NXCD; wgid = (xcd < r ? xcd * (q + 1) : r * (q + 1) + (xcd - r) * q) + off; }
        const int nig = WGM * nN, gid = wgid / nig, fm = gid * WGM, gsz = (nM - fm) < WGM ? (nM - fm) : WGM;
        u.pm = fm + ((wgid % nig) % gsz); u.pn = (wgid % nig) / gsz; u.pb = u.pn; u.pe = 0; return true;
    }
    __device__ __forceinline__ void a_ready(const Unit&) const {}
    __device__ __forceinline__ void done(const Unit&, int) const {}
};
struct MoeOrder {
    const int* tile_e; int nunits, ncol, G, c;
    __device__ bool next(int i, Unit& u) const {
        const long L = (long)i * G + c; if (L >= nunits) return false;
        u.pm = (int)L / ncol; u.pn = (int)L % ncol;
        const int e = __builtin_amdgcn_readfirstlane(__hip_atomic_load((int*)tile_e + u.pm, __ATOMIC_RELAXED, __HIP_MEMORY_SCOPE_AGENT));
        u.pb = u.pn; u.pe = e; return true;
    }
    __device__ __forceinline__ void a_ready(const Unit&) const {}
    __device__ __forceinline__ void done(const Unit&, int) const {}
};

typedef float f32x2_t __attribute__((ext_vector_type(2)));
typedef __bf16 bf16x2_t __attribute__((ext_vector_type(2)));
__device__ __forceinline__ unsigned cvt_pk_bf16(float lo, float hi) { const f32x2_t v = {lo, hi}; const bf16x2_t b = __builtin_convertvector(v, bf16x2_t); return __builtin_bit_cast(unsigned, b); }

struct EpiU {
    static constexpr bool PERM = true, AFTER_DRAIN = false;
    bf16_t* U; float* udt;
    __device__ __forceinline__ void operator()(const f32x4 (&acc)[2][2][4][2], const Unit& u, int wr, int wc, int fr, int fq) const {
        const int row0 = u.pm * BM + wr * 64 + fr;
        if (u.pn < 22) {
            const int col0 = u.pn * BM + wc * 32 + 8 * fq;
#pragma unroll
            for (int ai = 0; ai < 2; ++ai)
#pragma unroll
                for (int m = 0; m < 4; ++m) { bf16_t* rowp = U + (size_t)(row0 + ai * HALF + m * 16) * 5632 + col0;
#pragma unroll
                    for (int bj = 0; bj < 2; ++bj) { const f32x4 v0 = acc[ai][bj][m][0], v1 = acc[ai][bj][m][1];
                        u32x4 w; w.x = cvt_pk_bf16(v0[0], v0[1]); w.y = cvt_pk_bf16(v0[2], v0[3]); w.z = cvt_pk_bf16(v1[0], v1[1]); w.w = cvt_pk_bf16(v1[2], v1[3]);
                        *(u32x4*)(rowp + bj * HALF) = w; } }
        } else if (wc == 0 && fq < 2) {
#pragma unroll
            for (int ai = 0; ai < 2; ++ai)
#pragma unroll
                for (int m = 0; m < 4; ++m) { float* rowp = udt + (size_t)(row0 + ai * HALF + m * 16) * 16 + 8 * fq;
                    *(f32x4*)(rowp) = acc[ai][0][m][0]; *(f32x4*)(rowp + 4) = acc[ai][0][m][1]; }
        }
    }
};
struct EpiX1 {
    static constexpr bool PERM = false, AFTER_DRAIN = false;
    const float* X; float* O; const float* gate;
    __device__ __forceinline__ void operator()(const f32x4 (&acc)[2][2][4][2], const Unit& u, int wr, int wc, int fr, int fq) const {
        const int row0 = u.pm * BM + wr * 64 + fr, col0 = u.pn * BM + wc * 32 + 4 * fq;
        f32x4 gv[2][2];
#pragma unroll
        for (int bj = 0; bj < 2; ++bj)
#pragma unroll
            for (int n = 0; n < 2; ++n) gv[bj][n] = *(const f32x4*)(gate + col0 + bj * HALF + n * 16);
#pragma unroll
        for (int ai = 0; ai < 2; ++ai)
#pragma unroll
            for (int m = 0; m < 4; ++m) { const size_t ro = (size_t)(row0 + ai * HALF + m * 16) * 2048 + col0;
#pragma unroll
                for (int bj = 0; bj < 2; ++bj)
#pragma unroll
                    for (int n = 0; n < 2; ++n) { const f32x4 xv = *(const f32x4*)(X + ro + bj * HALF + n * 16);
                        *(f32x4*)(O + ro + bj * HALF + n * 16) = xv + gv[bj][n] * acc[ai][bj][m][n]; } }
    }
};
struct EpiHid {
    static constexpr bool PERM = true, AFTER_DRAIN = false;
    bf16_t* Hd;
    __device__ __forceinline__ void operator()(const f32x4 (&acc)[2][2][4][2], const Unit& u, int wr, int wc, int fr, int fq) const {
        const int row0 = u.pm * BM + wr * 64 + fr, col0 = u.pn * HALF + wc * 32 + 8 * fq;
#pragma unroll
        for (int ai = 0; ai < 2; ++ai)
#pragma unroll
            for (int m = 0; m < 4; ++m) { bf16_t* rowp = Hd + (size_t)(row0 + ai * HALF + m * 16) * 1024 + col0;
                float r[8];
#pragma unroll
                for (int n = 0; n < 2; ++n)
#pragma unroll
                    for (int j = 0; j < 4; ++j) { const float g = acc[ai][0][m][n][j], up = acc[ai][1][m][n][j]; r[4 * n + j] = g / (1.f + __expf(-g)) * up; }
                u32x4 w; w.x = cvt_pk_bf16(r[0], r[1]); w.y = cvt_pk_bf16(r[2], r[3]); w.z = cvt_pk_bf16(r[4], r[5]); w.w = cvt_pk_bf16(r[6], r[7]);
                *(u32x4*)(rowp) = w; }
    }
};
struct EpiY {
    static constexpr bool PERM = true, AFTER_DRAIN = false;
    bf16_t* Y;
    __device__ __forceinline__ void operator()(const f32x4 (&acc)[2][2][4][2], const Unit& u, int wr, int wc, int fr, int fq) const {
        const int row0 = u.pm * BM + wr * 64 + fr, col0 = u.pn * BM + wc * 32 + 8 * fq;
#pragma unroll
        for (int ai = 0; ai < 2; ++ai)
#pragma unroll
            for (int m = 0; m < 4; ++m) { bf16_t* rowp = Y + (size_t)(row0 + ai * HALF + m * 16) * 2048 + col0;
#pragma unroll
                for (int bj = 0; bj < 2; ++bj) { const f32x4 v0 = acc[ai][bj][m][0], v1 = acc[ai][bj][m][1];
                    u32x4 w; w.x = cvt_pk_bf16(v0[0], v0[1]); w.y = cvt_pk_bf16(v0[2], v0[3]); w.z = cvt_pk_bf16(v1[0], v1[1]); w.w = cvt_pk_bf16(v1[2], v1[3]);
                    *(u32x4*)(rowp + bj * HALF) = w; } }
    }
};

template <class Epi, class Sched, bool ALIGN_EPI = false, bool SP2 = false, bool BK8 = false>
__device__ __forceinline__ void gemm_phase(PG8_LAS unsigned char* lds, const Gemm g, const Sched& S, const Epi& E) {
    const int tid = threadIdx.x, wid = __builtin_amdgcn_readfirstlane(tid >> 6), lane = tid & 63, wr = wid >> 2, wc = wid & 3, fr = lane & 15, fq = lane >> 4;
    const int K = g.K, nt = K / BK;
    unsigned voffA[2], voffB[2];
#pragma unroll
    for (int i = 0; i < 2; ++i) { int R, C; stage_rc(tid * 16 + i * 8192, R, C); const int Rb = Epi::PERM ? ((R & ~31) + perm32(R & 31)) : R;
        voffA[i] = (unsigned)(R * K + C) * 2u; voffB[i] = BK8 ? (unsigned)((C >> 3) * g.N + Rb) * 16u : (unsigned)(Rb * K + C) * 2u; }
    const size_t kstepA = (size_t)(BK * 2), hstepA = (size_t)HALF * K * 2, tstepA = 2 * hstepA;
    const size_t kstepB = BK8 ? (size_t)128 * g.N : (size_t)(BK * 2), hstepB = BK8 ? (size_t)2048 : (size_t)HALF * K * 2;
#define PG8_BBASE(u) ((const char*)g.Bt + (BK8 ? (size_t)(u).pe * g.estep + (size_t)(u).pb * 4096 : (size_t)(u).pb * 2 * hstepB))
    const unsigned ldsw = (unsigned)wid * 1024u;
    const int aoff = lds_byte(wr * 64 + fr, fq * 8), boff = lds_byte(wc * 32 + fr, fq * 8);
#define PG8_SA(b, h) (((b) * 2 + (h)) * HTB)
#define PG8_SB(b, h) ((4 + (b) * 2 + (h)) * HTB)
#define PG8_STAGE(bufoff, gbase, voff) do { _Pragma("unroll") for (int _i = 0; _i < 2; ++_i) \
        __builtin_amdgcn_global_load_lds((const unsigned*)((const char*)(gbase) + (voff)[_i]), (PG8_LAS unsigned*)(lds + (bufoff) + ldsw + _i * 8192), 16, 0, 0); } while (0)
#define PG8_LDA(dst, b, h) do { _Pragma("unroll") for (int m = 0; m < 4; ++m) _Pragma("unroll") for (int k = 0; k < 2; ++k) dst[m][k] = *(const PG8_LAS bf16x8*)(lds + PG8_SA(b, h) + aoff + m * 2048 + k * 1024); } while (0)
#define PG8_LDB(dst, b, h) do { _Pragma("unroll") for (int n = 0; n < 2; ++n) _Pragma("unroll") for (int k = 0; k < 2; ++k) dst[n][k] = *(const PG8_LAS bf16x8*)(lds + PG8_SB(b, h) + boff + n * 2048 + k * 1024); } while (0)
#define PG8_MMA(ai, bj, At, Bt) do { __builtin_amdgcn_s_setprio(1); _Pragma("unroll") for (int m = 0; m < 4; ++m) _Pragma("unroll") for (int n = 0; n < 2; ++n) _Pragma("unroll") for (int k = 0; k < 2; ++k) \
        acc[ai][bj][m][n] = __builtin_amdgcn_mfma_f32_16x16x32_bf16(Bt[n][k], At[m][k], acc[ai][bj][m][n], 0, 0, 0); __builtin_amdgcn_s_setprio(0); } while (0)
#define PG8_WAIT_V(n) asm volatile("s_waitcnt vmcnt(" #n ")" ::: "memory")
#define PG8_WAIT_L(n) asm volatile("s_waitcnt lgkmcnt(" #n ")" ::: "memory")
#define PG8_BAR __builtin_amdgcn_s_barrier()
#define PG8_SCHED __builtin_amdgcn_sched_barrier(0)
    Unit cur, nxt; int ui = 0;
    if (!S.next(0, cur)) return;
    f32x4 acc[2][2][4][2];
#pragma unroll
    for (int a = 0; a < 2; ++a)
#pragma unroll
        for (int b = 0; b < 2; ++b)
#pragma unroll
            for (int m = 0; m < 4; ++m)
#pragma unroll
                for (int n = 0; n < 2; ++n) acc[a][b][m][n] = (f32x4){0.f, 0.f, 0.f, 0.f};
    bf16x8 At[4][2], B0[2][2], B1[2][2];
    const char* cA = (const char*)g.A + (size_t)cur.pm * tstepA; const char* cB = PG8_BBASE(cur);
    S.a_ready(cur);
    if constexpr (SP2) {
        PG8_STAGE(PG8_SB(0, 0), cB, voffB); PG8_STAGE(PG8_SB(0, 1), cB + hstepB, voffB); PG8_STAGE(PG8_SA(0, 0), cA, voffA); PG8_STAGE(PG8_SA(0, 1), cA + hstepA, voffA);
        if (wr == 1) PG8_BAR;
        PG8_WAIT_V(2); PG8_BAR;
        PG8_STAGE(PG8_SB(1, 0), cB + kstepB, voffB); PG8_STAGE(PG8_SA(1, 0), cA + kstepA, voffA); PG8_STAGE(PG8_SB(1, 1), cB + hstepB + kstepB, voffB);
        PG8_WAIT_V(6); PG8_BAR;
    } else {
        PG8_STAGE(PG8_SB(0, 0), cB, voffB); PG8_STAGE(PG8_SA(0, 0), cA, voffA); PG8_STAGE(PG8_SB(0, 1), cB + hstepB, voffB); PG8_STAGE(PG8_SA(0, 1), cA + hstepA, voffA);
        if (wr == 1) PG8_BAR;
        PG8_WAIT_V(4); PG8_BAR;
        PG8_STAGE(PG8_SB(1, 0), cB + kstepB, voffB); PG8_STAGE(PG8_SA(1, 0), cA + kstepA, voffA); PG8_STAGE(PG8_SB(1, 1), cB + hstepB + kstepB, voffB);
        PG8_WAIT_V(6); PG8_BAR;
    }
    for (;;) {
        const bool has_next = S.next(ui + 1, nxt);
        const char* nA = has_next ? (const char*)g.A + (size_t)nxt.pm * tstepA : cA; const char* nB = has_next ? PG8_BBASE(nxt) : cB;
        for (int t = 0; t < nt; t += 2) {
            const bool last = (t == nt - 2);
            const char* a1 = cA + (size_t)(t + 1) * kstepA;
            const char* a2 = last ? nA : cA + (size_t)(t + 2) * kstepA; const char* b2 = last ? nB : cB + (size_t)(t + 2) * kstepB;
            const char* a3 = a2 + kstepA; const char* b3 = b2 + kstepB;
            if (last && has_next) S.a_ready(nxt);
            if constexpr (SP2) {
            PG8_LDB(B0, 0, 0); PG8_LDB(B1, 0, 1); PG8_SCHED; PG8_LDA(At, 0, 0); PG8_STAGE(PG8_SA(1, 1), a1 + hstepA, voffA);
            PG8_WAIT_V(8); PG8_WAIT_L(0); PG8_BAR; PG8_MMA(0, 0, At, B0); PG8_MMA(0, 1, At, B1); PG8_BAR; PG8_SCHED;
            PG8_LDA(At, 0, 1); PG8_STAGE(PG8_SB(0, 0), b2, voffB); PG8_STAGE(PG8_SB(0, 1), b2 + hstepB, voffB); PG8_STAGE(PG8_SA(0, 0), a2, voffA);
            PG8_WAIT_V(8); PG8_WAIT_L(0); PG8_BAR; PG8_MMA(1, 0, At, B0); PG8_MMA(1, 1, At, B1); PG8_BAR; PG8_SCHED;
            PG8_LDB(B0, 1, 0); PG8_LDB(B1, 1, 1); PG8_SCHED; PG8_LDA(At, 1, 0); PG8_STAGE(PG8_SA(0, 1), a2 + hstepA, voffA);
            PG8_WAIT_V(8); PG8_WAIT_L(0); PG8_BAR; PG8_MMA(0, 0, At, B0); PG8_MMA(0, 1, At, B1); PG8_BAR; PG8_SCHED;
            PG8_LDA(At, 1, 1); PG8_STAGE(PG8_SB(1, 0), b3, voffB); PG8_STAGE(PG8_SB(1, 1), b3 + hstepB, voffB); PG8_STAGE(PG8_SA(1, 0), a3, voffA);
            PG8_WAIT_V(8); PG8_WAIT_L(0); PG8_BAR; PG8_MMA(1, 0, At, B0); PG8_MMA(1, 1, At, B1); PG8_BAR; PG8_SCHED;
            } else {
            PG8_LDB(B0, 0, 0); PG8_SCHED; PG8_LDA(At, 0, 0); PG8_STAGE(PG8_SA(1, 1), a1 + hstepA, voffA);
            PG8_WAIT_L(8); PG8_BAR; PG8_WAIT_L(0); PG8_MMA(0, 0, At, B0); PG8_BAR; PG8_SCHED;
            PG8_LDB(B1, 0, 1); PG8_STAGE(PG8_SB(0, 0), b2, voffB);
            PG8_BAR; PG8_WAIT_L(0); PG8_MMA(0, 1, At, B1); PG8_BAR;
            PG8_LDA(At, 0, 1); PG8_STAGE(PG8_SA(0, 0), a2, voffA);
            PG8_BAR; PG8_WAIT_L(0); PG8_MMA(1, 0, At, B0); PG8_BAR; PG8_SCHED;
            PG8_STAGE(PG8_SB(0, 1), b2 + hstepB, voffB);
            PG8_WAIT_V(6); PG8_BAR; PG8_MMA(1, 1, At, B1); PG8_BAR;
            PG8_LDB(B0, 1, 0); PG8_SCHED; PG8_LDA(At, 1, 0); PG8_STAGE(PG8_SA(0, 1), a2 + hstepA, voffA);
            PG8_WAIT_L(8); PG8_BAR; PG8_WAIT_L(0); PG8_MMA(0, 0, At, B0); PG8_BAR; PG8_SCHED;
            PG8_LDB(B1, 1, 1); PG8_STAGE(PG8_SB(1, 0), b3, voffB);
            PG8_BAR; PG8_WAIT_L(0); PG8_MMA(0, 1, At, B1); PG8_BAR;
            PG8_LDA(At, 1, 1); PG8_STAGE(PG8_SA(1, 0), a3, voffA);
            PG8_BAR; PG8_WAIT_L(0); PG8_MMA(1, 0, At, B0); PG8_BAR; PG8_SCHED;
            PG8_STAGE(PG8_SB(1, 1), b3 + hstepB, voffB);
            PG8_WAIT_V(6); PG8_BAR; PG8_MMA(1, 1, At, B1); PG8_BAR;
            }
        }
        if constexpr (ALIGN_EPI) { if (wr == 0) PG8_BAR; }
        if constexpr (!Epi::AFTER_DRAIN) { E(acc, cur, wr, wc, fr, fq); S.done(cur, ui); }
        if (!has_next) break;
#pragma unroll
        for (int a = 0; a < 2; ++a)
#pragma unroll
            for (int b = 0; b < 2; ++b)
#pragma unroll
                for (int m = 0; m < 4; ++m)
#pragma unroll
                    for (int n = 0; n < 2; ++n) acc[a][b][m][n] = (f32x4){0.f, 0.f, 0.f, 0.f};
        cur = nxt; cA = nA; cB = nB; ++ui;
        if constexpr (ALIGN_EPI) { if (wr == 1) PG8_BAR; }
    }
    PG8_WAIT_V(0);
    if constexpr (!ALIGN_EPI) { if (wr == 0) PG8_BAR; }
    PG8_BAR;
    if constexpr (Epi::AFTER_DRAIN) { E.fused(acc, cur, wr, wc, fr, fq, lds, wid, lane); S.done(cur, ui); }
#undef PG8_BBASE
#undef PG8_SA
#undef PG8_SB
#undef PG8_STAGE
#undef PG8_LDA
#undef PG8_LDB
#undef PG8_MMA
#undef PG8_WAIT_V
#undef PG8_WAIT_L
#undef PG8_BAR
#undef PG8_SCHED
}
}
#define XB_TMO      128
#define XB_XCNT(j)  (256  + 64 * (j))
#define XB_XSUB(j)  (1280 + 64 * (j))
#define XB_XGEN(j)  (2304 + 64 * (j))
#define XB_TOP      3328
#define XB_TOPGEN   3392
#define XCD_BAR_WORDS 3456
#define XB_SPIN_CAP (1u << 18)
#define LAS __attribute__((address_space(3)))

__device__ __forceinline__ unsigned xb_ld(unsigned* p)              { return __hip_atomic_load(p, __ATOMIC_RELAXED, __HIP_MEMORY_SCOPE_AGENT); }
__device__ __forceinline__ unsigned xb_add(unsigned* p, unsigned v) { return __hip_atomic_fetch_add(p, v, __ATOMIC_RELAXED, __HIP_MEMORY_SCOPE_AGENT); }
__device__ __forceinline__ unsigned xb_xcc_id() { return (unsigned)__builtin_amdgcn_s_getreg((3 << 11) | 20) & 0xFu; }
#define XB_SPIN(cond, bar) do { unsigned _sp = 0; while (cond) { __builtin_amdgcn_s_sleep(1); \
    if ((++_sp & 255u) == 0u) { if (xb_ld(&(bar)[XB_TMO])) break; if (_sp > XB_SPIN_CAP) { atomicAdd(&(bar)[XB_TMO], 1u); break; } } } } while (0)

struct XcdBarrier {
    unsigned* bar; unsigned x;
    volatile LAS unsigned* st;
};

__device__ __forceinline__ XcdBarrier xcd_barrier_post(unsigned* bar, volatile LAS unsigned* st) {
    XcdBarrier b; b.bar = bar; b.x = xb_xcc_id(); b.st = st;
    if (threadIdx.x == 0) (void)xb_add(&bar[XB_XCNT(b.x)], 1u);
    return b;
}
__device__ __forceinline__ void xcd_barrier_complete(unsigned* bar, unsigned x, unsigned& nloc, unsigned& nx) {
    const unsigned G = gridDim.x * gridDim.y * gridDim.z;
    unsigned sum, cnt, mine, sp = 0u;
    for (;;) {
        sum = 0u; cnt = 0u; mine = 0u;
#pragma unroll
        for (unsigned j = 0; j < 16; ++j) { const unsigned c = xb_ld(&bar[XB_XCNT(j)]); sum += c; cnt += (c > 0u) ? 1u : 0u; mine = (j == x) ? c : mine; }
        if (sum == G) break;
        __builtin_amdgcn_s_sleep(1);
        if ((++sp & 255u) == 0u) { if (xb_ld(&bar[XB_TMO])) break; if (sp > XB_SPIN_CAP) { atomicAdd(&bar[XB_TMO], 1u); break; } }
    }
    nloc = mine > 0u ? mine : 1u; nx = cnt > 0u ? cnt : 1u;
}

__device__ __forceinline__ void xcd_barrier(const XcdBarrier& b) {
    asm volatile("s_waitcnt vmcnt(0)" ::: "memory");
    __syncthreads();
    if (threadIdx.x == 0) {
        unsigned* bar = b.bar;
        __builtin_amdgcn_s_waitcnt(0);
        unsigned nloc = b.st[0], nx = b.st[1];
        if (nloc == 0u) { xcd_barrier_complete(bar, b.x, nloc, nx); b.st[0] = nloc; b.st[1] = nx; }
        const unsigned old = xb_add(&bar[XB_XSUB(b.x)], 1u);
        const unsigned gen = old / nloc;
        if (old + 1u == (gen + 1u) * nloc) {
            __builtin_amdgcn_fence(__ATOMIC_RELEASE, "agent");
            asm volatile("s_waitcnt vmcnt(0)" ::: "memory");
            const unsigned og = xb_add(&bar[XB_TOP], 1u);
            const unsigned tg = og / nx;
            if (og + 1u == (tg + 1u) * nx) xb_add(&bar[XB_TOPGEN], 1u);
            else XB_SPIN(xb_ld(&bar[XB_TOPGEN]) == tg, bar);
            __builtin_amdgcn_fence(__ATOMIC_ACQUIRE, "agent");
            xb_add(&bar[XB_XGEN(b.x)], 1u);
            asm volatile("s_waitcnt vmcnt(0)" ::: "memory");
        } else {
            XB_SPIN(xb_ld(&bar[XB_XGEN(b.x)]) == gen, bar);
            __builtin_amdgcn_fence(__ATOMIC_ACQUIRE, "agent");
            asm volatile("s_waitcnt vmcnt(0)" ::: "memory");
        }
    }
    __syncthreads();
}

constexpr int T = 16384, D = 2048, NTHR = 512, NWAVES = 8;
constexpr int NU = 5632;
constexpr int N_IN = 5648, N_IN_PAD = 5888;
constexpr int NCHUNK = 256;
constexpr int NE = 32, FF = 1024;
constexpr int MAX_TILES = 160;
constexpr float EPS = 1e-6f;
enum { IN_X = 0, IN_C, IN_WADA, IN_BADA, IN_N1W, IN_WIN, IN_CONVW, IN_SCONVW, IN_SCONVB, IN_DTB, IN_ALOG, IN_DSKIP, IN_SNW, IN_WOUT, IN_N2W, IN_WRG, IN_BRG, IN_WRE, IN_BRE, IN_WG, IN_WU, IN_WD, IN_FNW, N_INPUTS };

constexpr size_t KiB = 1024, MiB = 1u << 20;
constexpr size_t WS_CTL = 0, CTL_ZERO_BYTES = 1 * MiB;
constexpr size_t WS_MOD = 1 * MiB;
constexpr size_t WS_BIAS2 = 1 * MiB + 56 * KiB;
constexpr size_t WS_W2T = 1 * MiB + 64 * KiB;
constexpr size_t WS_BLKCNT = 1536 * KiB;
constexpr size_t WS_TILE = 1600 * KiB;
constexpr size_t WS_SLOT = 1664 * KiB;
constexpr size_t WS_EW = 1792 * KiB;
constexpr size_t WS_EID = 1920 * KiB;
constexpr size_t WS_RANK = 5 * MiB;
constexpr size_t WS_DT = 2 * MiB, WS_ACS = 3 * MiB, WS_UDT = 4 * MiB;
constexpr size_t WS_WIN = 8 * MiB;
constexpr size_t WS_WOUT = 32 * MiB;
constexpr size_t WS_WGU = 40 * MiB;
constexpr size_t WS_WD = 296 * MiB;
constexpr size_t WS_H = 424 * MiB;
constexpr size_t WS_U = 488 * MiB;
constexpr size_t WS_YMIX = 664 * MiB;
constexpr size_t WS_XS = 744 * MiB;
constexpr size_t WS_BM = 776 * MiB, WS_CM = 784 * MiB;
constexpr size_t WS_ST = 792 * MiB;
constexpr size_t WS_BMT = 856 * MiB;
constexpr size_t WS_YB = 744 * MiB;
constexpr size_t WS_END = 904 * MiB;
constexpr int CW_DBG = 16;
constexpr int CW_BAR = 4096;

constexpr int RING_BYTES = 131072;
constexpr int MISC_OFF = 131072;
constexpr int LDS_BYTES = 131072 + 1024;

#define GAS __attribute__((address_space(1)))
typedef unsigned short bf16;
typedef unsigned v4u __attribute__((ext_vector_type(4)));
typedef unsigned v2u __attribute__((ext_vector_type(2)));
typedef float f32x4 __attribute__((ext_vector_type(4)));
#define LDS_WAIT() asm volatile("s_waitcnt lgkmcnt(0)" ::: "memory")
__device__ __forceinline__ float bflo(unsigned u) { return __builtin_bit_cast(float, u << 16); }
__device__ __forceinline__ float bfhi(unsigned u) { return __builtin_bit_cast(float, u & 0xffff0000u); }
__device__ __forceinline__ unsigned pk2(float lo, float hi) { return pg8::cvt_pk_bf16(lo, hi); }
__device__ __forceinline__ float wave_sum(float v) {
#pragma unroll
    for (int o = 1; o < 64; o <<= 1) v += __shfl_xor(v, o);
    return v;
}
__device__ __forceinline__ float silu_f(float v) { return v / (1.f + __expf(-v)); }

struct Args { const float* in[N_INPUTS]; float* out; unsigned char* ws; int ph_lo, ph_hi, li, pad; };

struct Frame {
    LAS unsigned char* lds;
    int tid, lane, wave, G, vcu, bid;
    unsigned char* ws;
};

struct ConvJob { const float* wg; const float* wu; const float* wd; bf16* dgu; bf16* dd; };
__device__ __forceinline__ void k8_convert(const ConvJob& J, int it0, int nit, int lane) {
#pragma unroll 1
    for (int id = it0; id < it0 + nit; ++id) {
        const float* src; int ldw; bf16* dst; int rowadd = 0, gate_like = 0;
        if (id < 65536) { const int up = id >> 15, r0 = id & 32767, e = r0 >> 10, r = r0 & 1023, kb = r >> 2, nb = r & 3;
            src = (up ? J.wu : J.wg) + (size_t)e * D * FF + (size_t)(kb * 8) * FF + nb * 256 + lane; ldw = FF;
            dst = J.dgu + (size_t)e * 2048 * D + (size_t)kb * 2048 * 8; rowadd = (up ? 128 : 0) + nb * 512; gate_like = 1; }
        else { const int r0 = id - 65536, e = r0 >> 10, r = r0 & 1023, kb = r >> 3, nb = r & 7;
            src = J.wd + (size_t)e * FF * D + (size_t)(kb * 8) * D + nb * 256 + lane; ldw = D;
            dst = J.dd + (size_t)e * 2048 * FF + (size_t)kb * 2048 * 8; rowadd = nb * 256; }
        float v[4][8];
#pragma unroll
        for (int g = 0; g < 4; ++g)
#pragma unroll
            for (int i = 0; i < 8; ++i) v[g][i] = src[(size_t)i * ldw + 64 * g];
#pragma unroll
        for (int g = 0; g < 4; ++g) { const int c = 64 * g + lane; const int row = rowadd + (gate_like ? ((c >> 7) << 8) + (c & 127) : c);
            v4u o; o.x = pk2(v[g][0], v[g][1]); o.y = pk2(v[g][2], v[g][3]); o.z = pk2(v[g][4], v[g][5]); o.w = pk2(v[g][6], v[g][7]);
            *(v4u*)(dst + (size_t)row * 8) = o; }
    }
}
struct ConvOrder : pg8::StaticOrder {
    ConvJob J; int pos, it0, nit;
    __device__ __forceinline__ void done(const pg8::Unit&, int ui) const { if (ui == pos) k8_convert(J, it0, nit, (int)(threadIdx.x & 63)); }
};

__device__ __forceinline__ void p0_ada(const Frame& F, const float* cvec, const float* w_ada, const float* b_ada, float* mod) {
    LAS float* red = (LAS float*)F.lds;
    const int kq = F.tid / 12, cq = F.tid % 12;
    for (int chunk = F.vcu; chunk < 256; chunk += F.G) {
        if (F.tid < 504) {
            f32x4 acc = (f32x4){0.f, 0.f, 0.f, 0.f};
            const float* wp = w_ada + 48 * chunk + 4 * cq;
#pragma unroll 7
            for (int i = 0; i < 49; ++i) {
                const int k = kq + 42 * i; const bool ok = k < D; const int kk = ok ? k : 0;
                const float cv = cvec[kk]; const float s = ok ? cv / (1.f + expf(-cv)) : 0.f;
                const f32x4 w = *(const f32x4*)(wp + (size_t)kk * 12288);
                acc += s * w;
            }
            *(LAS f32x4*)(red + kq * 48 + 4 * cq) = acc;
        }
        __syncthreads();
        if (F.tid < 48) { float s = 0.f; for (int q = 0; q < 42; ++q) s += red[q * 48 + F.tid]; mod[48 * chunk + F.tid] = s + b_ada[48 * chunk + F.tid]; }
        __syncthreads();
    }
}
__device__ __forceinline__ void tr_item(const float* W, int ldw, int nvalid, int k0, int n0, bf16* dst, int ldd, LAS float* scr, int lane) {
    const int nn = n0 + (lane & 31); const bool ok = nn < nvalid; const int nc = ok ? nn : 0;
#pragma unroll 8
    for (int i = 0; i < 32; ++i) { const int kk = 2 * i + (lane >> 5); const float v = W[(size_t)(k0 + kk) * ldw + nc]; scr[kk * 33 + (lane & 31)] = ok ? v : 0.f; }
    LDS_WAIT();
    const int c = lane & 7;
#pragma unroll
    for (int j = 0; j < 4; ++j) { const int n = (lane >> 3) + 8 * j; const LAS float* s = scr + (8 * c) * 33 + n;
        v4u o; o.x = pk2(s[0 * 33], s[1 * 33]); o.y = pk2(s[2 * 33], s[3 * 33]); o.z = pk2(s[4 * 33], s[5 * 33]); o.w = pk2(s[6 * 33], s[7 * 33]);
        *(v4u*)(dst + (size_t)n * ldd + k0 + 8 * c) = o; }
    LDS_WAIT();
}
__device__ __forceinline__ void p0_convert(const Frame& F, const Args& a) {
    LAS float* scr = (LAS float*)(F.lds + 16384 + F.wave * 8704);
    bf16* Wt_in = (bf16*)(F.ws + WS_WIN); bf16* Wt_out = (bf16*)(F.ws + WS_WOUT);
    constexpr int I_IN = 32 * 177, I_OUT = 32 * 64, NITEMS = I_IN + I_OUT;
    const int gw = F.bid * NWAVES + F.wave, NGW = F.G * NWAVES;
    for (int it = gw; it < NITEMS; it += NGW) {
        int r = it;
        if (r < I_IN) { const int kb = r / 177, nb = r % 177; tr_item(a.in[IN_WIN], N_IN, N_IN, 64 * kb, 32 * nb, Wt_in + (size_t)(32 * nb) * D, D, scr, F.lane); continue; } r -= I_IN;
        { const int kb = r / 64, nb = r % 64; tr_item(a.in[IN_WOUT], D, D, 64 * kb, 32 * nb, Wt_out + (size_t)(32 * nb) * D, D, scr, F.lane); }
    }
    v4u* z = (v4u*)(Wt_in + (size_t)5664 * D); const int nz = 224 * D * 2 / 16;
    for (int i = F.bid * NTHR + F.tid; i < nz; i += F.G * NTHR) z[i] = (v4u){0u, 0u, 0u, 0u};
}

__device__ __forceinline__ void norm_rows(const Frame& F, const float* X, const float* nw, const float* sc, const float* sh, bf16* H) {
    f32x4 av[8], sv[8];
#pragma unroll
    for (int j = 0; j < 8; ++j) { const int k = 4 * F.lane + 256 * j; const f32x4 w = *(const f32x4*)(nw + k), s = *(const f32x4*)(sc + k); av[j] = w * (s + 1.f); sv[j] = *(const f32x4*)(sh + k); }
    const int gw = F.bid * NWAVES + F.wave, NGW = F.G * NWAVES;
    f32x4 nx[8];
    if (gw < T) {
#pragma unroll
        for (int j = 0; j < 8; ++j) nx[j] = ((const f32x4*)(X + (size_t)gw * D) + F.lane)[64 * j]; }
    for (int row = gw; row < T; row += NGW) {
        f32x4 v[8]; float s = 0.f;
#pragma unroll
        for (int j = 0; j < 8; ++j) { v[j] = nx[j]; s += (v[j].x * v[j].x + v[j].y * v[j].y) + (v[j].z * v[j].z + v[j].w * v[j].w); }
        if (row + NGW < T) {
#pragma unroll
            for (int j = 0; j < 8; ++j) nx[j] = ((const f32x4*)(X + (size_t)(row + NGW) * D) + F.lane)[64 * j]; }
        const float rstd = 1.f / sqrtf(wave_sum(s) * (1.f / D) + EPS);
        v2u* o = (v2u*)(H + (size_t)row * D) + F.lane;
#pragma unroll
        for (int j = 0; j < 8; ++j) { const f32x4 h = v[j] * rstd * av[j] + sv[j]; v2u w; w.x = pk2(h.x, h.y); w.y = pk2(h.z, h.w); o[64 * j] = w; }
    }
}
__device__ __forceinline__ void p1_router_prep(const Frame& F, const Args& a) {
    const float* mod = (const float*)(F.ws + WS_MOD); const float* sh2 = mod + 3 * D; const float* sc2 = mod + 4 * D;
    float* w2t = (float*)(F.ws + WS_W2T); float* bias2 = (float*)(F.ws + WS_BIAS2);
    const float* wrg = a.in[IN_WRG]; const float* wre = a.in[IN_WRE]; const float* n2w = a.in[IN_N2W];
    for (int i = F.bid * NTHR + F.tid; i < 48 * D; i += F.G * NTHR) {
        const int c = i / D, k = i % D; float v = 0.f;
        if (c < 36) { const float w = c < 4 ? wrg[k * 4 + c] : wre[k * 32 + (c - 4)]; v = w * n2w[k] * (1.f + sc2[k]); }
        w2t[i] = v;
    }
    if (F.bid == 0) {
        for (int c = F.wave; c < 48; c += NWAVES) { float s = 0.f;
            if (c < 36) { for (int k = F.lane; k < D; k += 64) { const float w = c < 4 ? wrg[k * 4 + c] : wre[k * 32 + (c - 4)]; s += sh2[k] * w; } s = wave_sum(s); s += c < 4 ? a.in[IN_BRG][c] : a.in[IN_BRE][c - 4]; }
            if (F.lane == 0) bias2[c] = s; }
    }
}

typedef short bf16x8 __attribute__((ext_vector_type(8)));
__device__ __forceinline__ f32x4 mma16(bf16x8 a, bf16x8 b, f32x4 c) { return __builtin_amdgcn_mfma_f32_16x16x32_bf16(a, b, c, 0, 0, 0); }

template <int MODE>
__device__ __forceinline__ void conv4_pair(const Frame& F, const Args& a, int c, int pp) {
    const int t0 = c * 64;
    const bf16* U = (const bf16*)(F.ws + WS_U);
    const float* cw = a.in[IN_SCONVW]; const float* cb = a.in[IN_SCONVB];
    float wa[4], wb[4];
#pragma unroll
    for (int j = 0; j < 4; ++j) { wa[j] = cw[j * 1536 + 2 * pp]; wb[j] = cw[j * 1536 + 2 * pp + 1]; }
    const float bia = cb[2 * pp], bib = cb[2 * pp + 1];
    float p3a = 0.f, p3b = 0.f, p2a = 0.f, p2b = 0.f, p1a = 0.f, p1b = 0.f;
    if (c > 0) {
        const unsigned u3 = ((const unsigned*)(U + (size_t)(t0 - 3) * NU + 4096))[pp], u2 = ((const unsigned*)(U + (size_t)(t0 - 2) * NU + 4096))[pp], u1 = ((const unsigned*)(U + (size_t)(t0 - 1) * NU + 4096))[pp];
        p3a = bflo(u3); p3b = bfhi(u3); p2a = bflo(u2); p2b = bfhi(u2); p1a = bflo(u1); p1b = bfhi(u1);
    }
    bf16* xsT = (bf16*)(F.ws + WS_XS); bf16* Bm = (bf16*)(F.ws + WS_BM); bf16* Cm = (bf16*)(F.ws + WS_CM); bf16* BmT = (bf16*)(F.ws + WS_BMT);
    unsigned un[8];
#pragma unroll
    for (int i = 0; i < 8; ++i) un[i] = ((const unsigned*)(U + (size_t)(t0 + i) * NU + 4096))[pp];
#pragma unroll
    for (int tb = 0; tb < 8; ++tb) {
        unsigned uu[8];
#pragma unroll
        for (int i = 0; i < 8; ++i) uu[i] = un[i];
        if (tb < 7) {
#pragma unroll
            for (int i = 0; i < 8; ++i) un[i] = ((const unsigned*)(U + (size_t)(t0 + (tb + 1) * 8 + i) * NU + 4096))[pp]; }
        float ya[8], yb[8];
#pragma unroll
        for (int i = 0; i < 8; ++i) { const float ua = bflo(uu[i]), ub = bfhi(uu[i]);
            ya[i] = silu_f(wa[0] * p3a + wa[1] * p2a + wa[2] * p1a + wa[3] * ua + bia); yb[i] = silu_f(wb[0] * p3b + wb[1] * p2b + wb[2] * p1b + wb[3] * ub + bib);
            p3a = p2a; p3b = p2b; p2a = p1a; p2b = p1b; p1a = ua; p1b = ub; }
        if (MODE != 2) { v4u va, vb;
#pragma unroll
            for (int q = 0; q < 4; ++q) { va[q] = pk2(ya[2 * q], ya[2 * q + 1]); vb[q] = pk2(yb[2 * q], yb[2 * q + 1]); }
            if (MODE == 0) { bf16* o = xsT + ((size_t)c * 1024 + 2 * pp) * 64 + tb * 8; *(v4u*)o = va; *(v4u*)(o + 64) = vb; }
            else { bf16* o = BmT + ((size_t)c * 256 + 2 * (pp - 512)) * 64 + tb * 8; *(v4u*)o = va; *(v4u*)(o + 64) = vb; } }
        if (MODE == 1) {
#pragma unroll
            for (int i = 0; i < 8; ++i) ((unsigned*)(Bm + (size_t)(t0 + tb * 8 + i) * 256))[pp - 512] = pk2(ya[i], yb[i]); }
        if (MODE == 2) {
#pragma unroll
            for (int i = 0; i < 8; ++i) ((unsigned*)(Cm + (size_t)(t0 + tb * 8 + i) * 256))[pp - 640] = pk2(ya[i], yb[i]); }
    }
}

__device__ __forceinline__ void p3_chunk(const Frame& F, const Args& a, int c) {
    const int t0 = c * 64, tid = F.tid;
    const bf16* U = (const bf16*)(F.ws + WS_U); bf16* ymix = (bf16*)(F.ws + WS_YMIX);
    {
        const float* cw = a.in[IN_CONVW];
        const float w0a = cw[2 * tid], w0b = cw[2 * tid + 1], w1a = cw[1024 + 2 * tid], w1b = cw[1024 + 2 * tid + 1], w2a = cw[2048 + 2 * tid], w2b = cw[2048 + 2 * tid + 1];
        float p2a = 0.f, p2b = 0.f, p1a = 0.f, p1b = 0.f;
        if (c > 0) { const unsigned* u2 = (const unsigned*)(U + (size_t)(t0 - 2) * NU); const unsigned* u1 = (const unsigned*)(U + (size_t)(t0 - 1) * NU);
            const unsigned c2 = u2[512 + tid], v2 = u2[1024 + tid], c1 = u1[512 + tid], v1 = u1[1024 + tid];
            p2a = bflo(c2) * bflo(v2); p2b = bfhi(c2) * bfhi(v2); p1a = bflo(c1) * bflo(v1); p1b = bfhi(c1) * bfhi(v1); }
        unsigned nb_[8], nc_[8], nv_[8];
#pragma unroll
        for (int i = 0; i < 8; ++i) { const unsigned* ur = (const unsigned*)(U + (size_t)(t0 + i) * NU); nb_[i] = ur[tid]; nc_[i] = ur[512 + tid]; nv_[i] = ur[1024 + tid]; }
#pragma unroll
        for (int tb = 0; tb < 8; ++tb) {
            unsigned cb_[8], cc_[8], cv_[8];
#pragma unroll
            for (int i = 0; i < 8; ++i) { cb_[i] = nb_[i]; cc_[i] = nc_[i]; cv_[i] = nv_[i]; }
            if (tb < 7) {
#pragma unroll
                for (int i = 0; i < 8; ++i) { const unsigned* ur = (const unsigned*)(U + (size_t)(t0 + (tb + 1) * 8 + i) * NU); nb_[i] = ur[tid]; nc_[i] = ur[512 + tid]; nv_[i] = ur[1024 + tid]; } }
#pragma unroll
            for (int i = 0; i < 8; ++i) {
                const float cva = bflo(cc_[i]) * bflo(cv_[i]), cvb = bfhi(cc_[i]) * bfhi(cv_[i]);
                const float ya = bflo(cb_[i]) * (w0a * p2a + w1a * p1a + w2a * cva), yb = bfhi(cb_[i]) * (w0b * p2b + w1b * p1b + w2b * cvb);
                ((unsigned*)(ymix + (size_t)(t0 + tb * 8 + i) * D))[tid] = pk2(ya, yb);
                p2a = p1a; p2b = p1b; p1a = cva; p1b = cvb;
            }
        }
    }
    conv4_pair<0>(F, a, c, tid);
    if (tid < 128) conv4_pair<1>(F, a, c, tid + 512); else if (tid < 256) conv4_pair<2>(F, a, c, tid + 512);
    float* dtT = (float*)(F.ws + WS_DT); float* acsT = (float*)(F.ws + WS_ACS); const float* udt = (const float*)(F.ws + WS_UDT);
#pragma unroll
    for (int hi = 0; hi < 2; ++hi) {
        const int h = F.wave + 8 * hi; const float bias = a.in[IN_DTB][h], A = -expf(a.in[IN_ALOG][h]);
        const float x = udt[(size_t)(t0 + F.lane) * 16 + h] + bias; const float dt = fmaxf(x, 0.f) + log1pf(expf(-fabsf(x)));
        float cs = A * dt;
#pragma unroll
        for (int o = 1; o < 64; o <<= 1) { const float v = __shfl_up(cs, o); cs += (F.lane >= o) ? v : 0.f; }
        dtT[((size_t)c * 16 + h) * 64 + F.lane] = dt; acsT[((size_t)c * 16 + h) * 64 + F.lane] = cs;
    }
    asm volatile("s_waitcnt vmcnt(0)" ::: "memory");
    __syncthreads();
    const bf16* xsT = (const bf16*)(F.ws + WS_XS); const bf16* BmT = (const bf16*)(F.ws + WS_BMT); bf16* st = (bf16*)(F.ws + WS_ST);
    const int fr = F.lane & 15, fq = F.lane >> 4;
#pragma unroll 1
    for (int hi = 0; hi < 2; ++hi) {
        const int h = F.wave + 8 * hi, g = h >> 3;
        const float* dT = dtT + ((size_t)c * 16 + h) * 64; const float* aT = acsT + ((size_t)c * 16 + h) * 64; const float a63 = aT[63];
        bf16x8 xb[4][2];
#pragma unroll
        for (int ks = 0; ks < 2; ++ks) {
            const f32x4 d0 = *(const f32x4*)(dT + 32 * ks + 8 * fq), d1 = *(const f32x4*)(dT + 32 * ks + 8 * fq + 4), a0 = *(const f32x4*)(aT + 32 * ks + 8 * fq), a1 = *(const f32x4*)(aT + 32 * ks + 8 * fq + 4);
            float w[8];
#pragma unroll
            for (int j = 0; j < 4; ++j) { w[j] = d0[j] * __expf(a63 - a0[j]); w[4 + j] = d1[j] * __expf(a63 - a1[j]); }
#pragma unroll
            for (int nb = 0; nb < 4; ++nb) { const v4u raw = *(const v4u*)(xsT + ((size_t)c * 1024 + h * 64 + nb * 16 + fr) * 64 + 32 * ks + 8 * fq); v4u sc;
#pragma unroll
                for (int q = 0; q < 4; ++q) sc[q] = pk2(bflo(raw[q]) * w[2 * q], bfhi(raw[q]) * w[2 * q + 1]);
                xb[nb][ks] = __builtin_bit_cast(bf16x8, sc); }
        }
#pragma unroll 1
        for (int half = 0; half < 2; ++half) {
            f32x4 acc[4][4];
#pragma unroll
            for (int mb = 0; mb < 4; ++mb)
#pragma unroll
                for (int nb = 0; nb < 4; ++nb) acc[mb][nb] = (f32x4){0.f, 0.f, 0.f, 0.f};
#pragma unroll
            for (int ks = 0; ks < 2; ++ks)
#pragma unroll
                for (int mb = 0; mb < 4; ++mb) { const bf16x8 av = *(const bf16x8*)(BmT + ((size_t)c * 256 + g * 128 + half * 64 + mb * 16 + fr) * 64 + 32 * ks + 8 * fq);
#pragma unroll
                    for (int nb = 0; nb < 4; ++nb) acc[mb][nb] = mma16(av, xb[nb][ks], acc[mb][nb]); }
#pragma unroll
            for (int mb = 0; mb < 4; ++mb)
#pragma unroll
                for (int nb = 0; nb < 4; ++nb) { v2u w; w.x = pk2(acc[mb][nb][0], acc[mb][nb][1]); w.y = pk2(acc[mb][nb][2], acc[mb][nb][3]);
                    *(v2u*)(st + (((size_t)c * 16 + h) * 64 + nb * 16 + fr) * 128 + half * 64 + mb * 16 + 4 * fq) = w; }
        }
    }
}

__device__ __forceinline__ void p_scan(const Frame& F) {
    bf16* st = (bf16*)(F.ws + WS_ST); const float* acsT = (const float*)(F.ws + WS_ACS);
    for (int e = F.bid * NTHR + F.tid; e < 16 * 64 * 128; e += F.G * NTHR) {
        const int head = e >> 13; float h = 0.f;
#pragma unroll 1
        for (int cb = 0; cb < NCHUNK; cb += 32) {
            unsigned short sv[32]; float dv[32];
#pragma unroll
            for (int i = 0; i < 32; ++i) { sv[i] = st[(size_t)(cb + i) * 131072 + e]; dv[i] = acsT[((size_t)(cb + i) * 16 + head) * 64 + 63]; }
#pragma unroll
            for (int i = 0; i < 32; ++i) { st[(size_t)(cb + i) * 131072 + e] = (bf16)(pk2(h, 0.f) & 0xffffu); h = h * __expf(dv[i]) + bflo((unsigned)sv[i]); }
        }
    }
}

__device__ __forceinline__ void p4_unit(const Frame& F, const Args& a, int c, int g) {
    const int t0 = c * 64, hh = F.wave, h = g * 8 + hh, fr = F.lane & 15, fq = F.lane >> 4;
    const bf16* U = (const bf16*)(F.ws + WS_U); bf16* ymix = (bf16*)(F.ws + WS_YMIX);
    const bf16* xsT = (const bf16*)(F.ws + WS_XS); const bf16* Bm = (const bf16*)(F.ws + WS_BM); const bf16* Cm = (const bf16*)(F.ws + WS_CM);
    const float* dT = (const float*)(F.ws + WS_DT) + ((size_t)c * 16 + h) * 64; const float* aT = (const float*)(F.ws + WS_ACS) + ((size_t)c * 16 + h) * 64;
    const bf16* pv = (const bf16*)(F.ws + WS_ST) + ((size_t)c * 16 + h) * 64 * 128;
    LAS unsigned char* mbuf = F.lds + hh * 9216;
    LAS float* sred = (LAS float*)(F.lds + 73728);
    LAS float* srs = (LAS float*)(F.lds + 75776);
    float al[4];
#pragma unroll
    for (int nb = 0; nb < 4; ++nb) al[nb] = aT[nb * 16 + fr];
    bf16x8 cf[4][4];
#pragma unroll
    for (int nb = 0; nb < 4; ++nb)
#pragma unroll
        for (int ks = 0; ks < 4; ++ks) cf[nb][ks] = *(const bf16x8*)(Cm + (size_t)(t0 + nb * 16 + fr) * 256 + g * 128 + 32 * ks + 8 * fq);
    f32x4 acc[4][4];
#pragma unroll
    for (int mb = 0; mb < 4; ++mb)
#pragma unroll
        for (int nb = 0; nb < 4; ++nb) acc[mb][nb] = (f32x4){0.f, 0.f, 0.f, 0.f};
#pragma unroll
    for (int ks = 0; ks < 4; ++ks)
#pragma unroll
        for (int mb = 0; mb < 4; ++mb) { const bf16x8 bv = *(const bf16x8*)(Bm + (size_t)(t0 + mb * 16 + fr) * 256 + g * 128 + 32 * ks + 8 * fq);
#pragma unroll
            for (int nb = 0; nb < 4; ++nb) acc[mb][nb] = mma16(bv, cf[nb][ks], acc[mb][nb]); }
    {
        const float dsk = a.in[IN_DSKIP][h];
#pragma unroll
        for (int mb = 0; mb < 4; ++mb) { const f32x4 as = *(const f32x4*)(aT + mb * 16 + 4 * fq), ds = *(const f32x4*)(dT + mb * 16 + 4 * fq);
#pragma unroll
            for (int nb = 0; nb < 4; ++nb) { const int l = nb * 16 + fr; float m[4];
#pragma unroll
                for (int r = 0; r < 4; ++r) { const int s = mb * 16 + 4 * fq + r; const float v = acc[mb][nb][r] * __expf(al[nb] - as[r]) * ds[r]; m[r] = (s <= l) ? v : 0.f; m[r] += (s == l) ? dsk : 0.f; }
                v2u w; w.x = pk2(m[0], m[1]); w.y = pk2(m[2], m[3]);
                *(LAS v2u*)(mbuf + l * 144 + (mb * 16 + 4 * fq) * 2) = w; } }
    }
#pragma unroll
    for (int mb = 0; mb < 4; ++mb)
#pragma unroll
        for (int nb = 0; nb < 4; ++nb) acc[mb][nb] = (f32x4){0.f, 0.f, 0.f, 0.f};
#pragma unroll
    for (int ks = 0; ks < 4; ++ks)
#pragma unroll
        for (int mb = 0; mb < 4; ++mb) { const bf16x8 pvv = *(const bf16x8*)(pv + (size_t)(mb * 16 + fr) * 128 + 32 * ks + 8 * fq);
#pragma unroll
            for (int nb = 0; nb < 4; ++nb) acc[mb][nb] = mma16(pvv, cf[nb][ks], acc[mb][nb]); }
#pragma unroll
    for (int nb = 0; nb < 4; ++nb) { const float ea = __expf(al[nb]);
#pragma unroll
        for (int mb = 0; mb < 4; ++mb) acc[mb][nb] = acc[mb][nb] * ea; }
    LDS_WAIT();
#pragma unroll
    for (int ks = 0; ks < 2; ++ks) {
        bf16x8 mf[4];
#pragma unroll
        for (int nb = 0; nb < 4; ++nb) mf[nb] = *(const LAS bf16x8*)(mbuf + (nb * 16 + fr) * 144 + (32 * ks + 8 * fq) * 2);
#pragma unroll
        for (int mb = 0; mb < 4; ++mb) { const bf16x8 xv = *(const bf16x8*)(xsT + ((size_t)c * 1024 + h * 64 + mb * 16 + fr) * 64 + 32 * ks + 8 * fq);
#pragma unroll
            for (int nb = 0; nb < 4; ++nb) acc[mb][nb] = mma16(xv, mf[nb], acc[mb][nb]); }
    }
    float ss[4] = {0.f, 0.f, 0.f, 0.f};
#pragma unroll
    for (int nb = 0; nb < 4; ++nb)
#pragma unroll
        for (int mb = 0; mb < 4; ++mb) { const v2u zv = *(const v2u*)(U + (size_t)(t0 + nb * 16 + fr) * NU + 3072 + h * 64 + mb * 16 + 4 * fq);
            f32x4 y = acc[mb][nb]; y[0] *= silu_f(bflo(zv.x)); y[1] *= silu_f(bfhi(zv.x)); y[2] *= silu_f(bflo(zv.y)); y[3] *= silu_f(bfhi(zv.y));
            acc[mb][nb] = y; ss[nb] += (y[0] * y[0] + y[1] * y[1]) + (y[2] * y[2] + y[3] * y[3]); }
#pragma unroll
    for (int nb = 0; nb < 4; ++nb) { float s = ss[nb]; s += __shfl_xor(s, 16); s += __shfl_xor(s, 32); if (fq == 0) sred[hh * 64 + nb * 16 + fr] = s; }
    __syncthreads();
    if (F.tid < 64) { float s = 0.f;
#pragma unroll
        for (int w = 0; w < 8; ++w) s += sred[w * 64 + F.tid];
        srs[F.tid] = 1.f / sqrtf(s * (1.f / 512.f) + EPS); }
    __syncthreads();
    {
        const float* nw = a.in[IN_SNW] + h * 64;
#pragma unroll
        for (int nb = 0; nb < 4; ++nb) { const float r = srs[nb * 16 + fr];
#pragma unroll
            for (int mb = 0; mb < 4; ++mb) { const f32x4 n4 = *(const f32x4*)(nw + mb * 16 + 4 * fq); const f32x4 y = acc[mb][nb] * r * n4;
                v2u w; w.x = pk2(y[0], y[1]); w.y = pk2(y[2], y[3]);
                *(v2u*)(ymix + (size_t)(t0 + nb * 16 + fr) * D + 1024 + h * 64 + mb * 16 + 4 * fq) = w; } }
    }
    __syncthreads();
}

__device__ __forceinline__ void p6_unit(const Frame& F, const Args& a, int u) {
    const int t0 = u * 64, tid = F.tid, lane = F.lane, wave = F.wave;
    const float* X1 = a.out; const float* w2t = (const float*)(F.ws + WS_W2T); const float* bias2 = (const float*)(F.ws + WS_BIAS2);
    const float* mod = (const float*)(F.ws + WS_MOD);
    LAS float* spart = (LAS float*)F.lds;
    LAS float* sssq = (LAS float*)(F.lds + 98304);
    LAS float* srstd = (LAS float*)(F.lds + 100352);
    LAS int* seid = (LAS int*)(F.lds + 100608);
    LAS int* shist = (LAS int*)(F.lds + 101120);
    const int r16 = lane & 15, q = lane >> 4, k0 = wave * 256 + 4 * q;
    f32x4 acc[4][3];
#pragma unroll
    for (int rb = 0; rb < 4; ++rb)
#pragma unroll
        for (int cb = 0; cb < 3; ++cb) acc[rb][cb] = (f32x4){0.f, 0.f, 0.f, 0.f};
    float ssq[4] = {0.f, 0.f, 0.f, 0.f};
    const float* xrow = X1 + (size_t)(t0 + r16) * D + k0;
    const float* wrow = w2t + (size_t)r16 * D + k0;
#pragma unroll 2
    for (int s = 0; s < 16; ++s) {
        f32x4 av[4], bv[3];
#pragma unroll
        for (int rb = 0; rb < 4; ++rb) av[rb] = *(const f32x4*)(xrow + (size_t)rb * 16 * D + 16 * s);
#pragma unroll
        for (int cb = 0; cb < 3; ++cb) bv[cb] = *(const f32x4*)(wrow + (size_t)cb * 16 * D + 16 * s);
#pragma unroll
        for (int rb = 0; rb < 4; ++rb) ssq[rb] += (av[rb].x * av[rb].x + av[rb].y * av[rb].y) + (av[rb].z * av[rb].z + av[rb].w * av[rb].w);
#pragma unroll
        for (int e = 0; e < 4; ++e)
#pragma unroll
            for (int rb = 0; rb < 4; ++rb)
#pragma unroll
                for (int cb = 0; cb < 3; ++cb) acc[rb][cb] = __builtin_amdgcn_mfma_f32_16x16x4f32(av[rb][e], bv[cb][e], acc[rb][cb], 0, 0, 0);
    }
#pragma unroll
    for (int rb = 0; rb < 4; ++rb)
#pragma unroll
        for (int cb = 0; cb < 3; ++cb)
#pragma unroll
            for (int r = 0; r < 4; ++r) spart[(wave * 64 + rb * 16 + 4 * q + r) * 48 + cb * 16 + r16] = acc[rb][cb][r];
#pragma unroll
    for (int rb = 0; rb < 4; ++rb) { float s = ssq[rb]; s += __shfl_xor(s, 16); s += __shfl_xor(s, 32); if (q == 0) sssq[wave * 64 + rb * 16 + r16] = s; }
    if (tid < 32) shist[tid] = 0;
    __syncthreads();
    LAS float* slog = (LAS float*)(F.lds + 102400);
    for (int i = tid; i < 64 * 48; i += NTHR) { float v = 0.f;
#pragma unroll
        for (int w = 0; w < 8; ++w) v += spart[w * 64 * 48 + i];
        slog[i] = v; }
    if (tid < 64) { float s = 0.f;
#pragma unroll
        for (int w = 0; w < 8; ++w) s += sssq[w * 64 + tid];
        srstd[tid] = 1.f / sqrtf(s * (1.f / D) + EPS); }
    __syncthreads();
    if (tid < 64) {
        const float rstd = srstd[tid];
        float lg[36];
#pragma unroll
        for (int c = 0; c < 36; ++c) lg[c] = slog[tid * 48 + c] * rstd + bias2[c];
        int gi = 0; float gm = lg[0];
#pragma unroll
        for (int c = 1; c < 4; ++c) if (lg[c] > gm) { gm = lg[c]; gi = c; }
        float gs = 0.f;
#pragma unroll
        for (int c = 0; c < 4; ++c) gs += expf(lg[c] - gm);
        const float grp_p = 1.f / gs;
        float le[8];
#pragma unroll
        for (int j = 0; j < 8; ++j) { float v = lg[4 + j];
#pragma unroll
            for (int g2 = 1; g2 < 4; ++g2) v = (gi == g2) ? lg[4 + g2 * 8 + j] : v;
            le[j] = v; }
        int j1 = 0; float m1 = le[0];
#pragma unroll
        for (int j = 1; j < 8; ++j) if (le[j] > m1) { m1 = le[j]; j1 = j; }
        int j2 = -1; float m2 = -3.0e38f;
#pragma unroll
        for (int j = 0; j < 8; ++j) if (j != j1 && le[j] > m2) { m2 = le[j]; j2 = j; }
        const float e2 = expf(m2 - m1), w1 = grp_p / (1.f + e2), w2 = grp_p * e2 / (1.f + e2);
        const int ex1 = gi * 8 + j1, ex2 = gi * 8 + j2, t = t0 + tid;
        ((int*)(F.ws + WS_EID))[2 * t] = ex1; ((int*)(F.ws + WS_EID))[2 * t + 1] = ex2;
        ((float*)(F.ws + WS_EW))[2 * t] = w1; ((float*)(F.ws + WS_EW))[2 * t + 1] = w2;
        seid[2 * tid] = ex1; seid[2 * tid + 1] = ex2;
        __hip_atomic_fetch_add(&shist[ex1], 1, __ATOMIC_RELAXED, __HIP_MEMORY_SCOPE_WORKGROUP); __hip_atomic_fetch_add(&shist[ex2], 1, __ATOMIC_RELAXED, __HIP_MEMORY_SCOPE_WORKGROUP);
    }
    __syncthreads();
    if (tid < 32) ((int*)(F.ws + WS_BLKCNT))[u * 32 + tid] = shist[tid];
    if (tid < 128) { const int e = seid[tid]; int r = 0; for (int j = 0; j < tid; ++j) r += (seid[j] == e) ? 1 : 0; ((int*)(F.ws + WS_RANK))[2 * t0 + tid] = r; }
    {
        const float* n2w = a.in[IN_N2W]; const float* sh2 = mod + 3 * D; const float* sc2 = mod + 4 * D; bf16* H = (bf16*)(F.ws + WS_H);
        f32x4 av2[8], bv2[8];
#pragma unroll
        for (int j = 0; j < 8; ++j) { const int k = 4 * lane + 256 * j; const f32x4 w = *(const f32x4*)(n2w + k), s = *(const f32x4*)(sc2 + k); av2[j] = w * (s + 1.f); bv2[j] = *(const f32x4*)(sh2 + k); }
#pragma unroll 1
        for (int i = 0; i < 8; i += 2) {
            f32x4 xv[2][8];
#pragma unroll
            for (int u2 = 0; u2 < 2; ++u2)
#pragma unroll
                for (int j = 0; j < 8; ++j) xv[u2][j] = ((const f32x4*)(X1 + (size_t)(t0 + wave * 8 + i + u2) * D) + lane)[64 * j];
#pragma unroll
            for (int u2 = 0; u2 < 2; ++u2) { const int tok = wave * 8 + i + u2; const float rstd = srstd[tok]; v2u* o = (v2u*)(H + (size_t)(t0 + tok) * D) + lane;
#pragma unroll
                for (int j = 0; j < 8; ++j) { const f32x4 hv = xv[u2][j] * rstd * av2[j] + bv2[j]; v2u pw; pw.x = pk2(hv.x, hv.y); pw.y = pk2(hv.z, hv.w); o[64 * j] = pw; } }
        }
    }
    __syncthreads();
}

__device__ __forceinline__ void p7_unit(const Frame& F, int u) {
    const int t0 = u * 64, tid = F.tid;
    const int* blkcnt = (const int*)(F.ws + WS_BLKCNT); int* slot = (int*)(F.ws + WS_SLOT); const int* eid = (const int*)(F.ws + WS_EID);
    LAS int* stot = (LAS int*)F.lds;
    LAS int* sbef = (LAS int*)(F.lds + 128);
    LAS int* sbase = (LAS int*)(F.lds + 256);
    LAS int* sslot = (LAS int*)(F.lds + 512);
    LAS int* scnt = (LAS int*)(F.lds + 1024);
    for (int i = tid; i < NCHUNK * 32 / 4; i += NTHR) *(LAS v4u*)(scnt + 4 * i) = *(const v4u*)(blkcnt + 4 * i);
    __syncthreads();
    if (tid < 32) { int tot = 0, bef = 0;
#pragma unroll 8
        for (int b = 0; b < NCHUNK; ++b) { const int v = scnt[b * 32 + tid]; tot += v; bef += (b < u) ? v : 0; } stot[tid] = tot; sbef[tid] = bef; }
    __syncthreads();
    if (tid == 0) { int ps = 0; for (int e = 0; e < 32; ++e) { sbase[e] = ps + sbef[e];
            if (u == 0) { int* tile_e = (int*)(F.ws + WS_TILE); for (int i = ps >> 8; i < ((ps + ((stot[e] + 255) & ~255)) >> 8); ++i) tile_e[i] = e; }
            ps += (stot[e] + 255) & ~255; }
        if (u == 0) ((int*)(F.ws + WS_TILE))[192] = ps >> 8; }
    __syncthreads();
    if (tid < 128) { const int s = sbase[eid[2 * t0 + tid]] + ((const int*)(F.ws + WS_RANK))[2 * t0 + tid]; sslot[tid] = s; slot[2 * t0 + tid] = s; }
    __syncthreads();
    const bf16* H = (const bf16*)(F.ws + WS_H); bf16* hs = (bf16*)(F.ws + WS_U);
    for (int i = 0; i < 16; ++i) { const int a = F.wave * 16 + i, s = sslot[a]; const v4u* src = (const v4u*)(H + (size_t)(t0 + (a >> 1)) * D) + F.lane; v4u* dst = (v4u*)(hs + (size_t)s * D) + F.lane;
#pragma unroll
        for (int j = 0; j < 4; ++j) dst[64 * j] = src[64 * j]; }
    __syncthreads();
}

__device__ __forceinline__ void p10_rows(const Frame& F, const Args& a) {
    const float* mod = (const float*)(F.ws + WS_MOD); const float* g2 = mod + 5 * D; const float* fw = a.in[IN_FNW];
    const int* slot = (const int*)(F.ws + WS_SLOT); const float* ew = (const float*)(F.ws + WS_EW); const bf16* yb = (const bf16*)(F.ws + WS_YB);
    float dbg = 0.f;
#if defined(MK_DEBUG_CHECK)
    dbg = __builtin_bit_cast(float, __hip_atomic_load((unsigned*)(F.ws + WS_CTL) + CW_DBG, __ATOMIC_RELAXED, __HIP_MEMORY_SCOPE_AGENT));
#endif
    const int gw = F.bid * NWAVES + F.wave, NGW = F.G * NWAVES;
    f32x4 gv[8], fv[8];
#pragma unroll
    for (int j = 0; j < 8; ++j) { const int k = 4 * F.lane + 256 * j; gv[j] = *(const f32x4*)(g2 + k); fv[j] = *(const f32x4*)(fw + k); }
    f32x4 nx[8]; v2u ny0[8], ny1[8]; float nw0 = 0.f, nw1 = 0.f;
#define P10_LOAD(row_) do { const int s0_ = slot[2 * (row_)], s1_ = slot[2 * (row_) + 1]; nw0 = ew[2 * (row_)]; nw1 = ew[2 * (row_) + 1]; \
        const float* xr_ = a.out + (size_t)(row_) * D; const v2u* y0_ = (const v2u*)(yb + (size_t)s0_ * D) + F.lane; const v2u* y1_ = (const v2u*)(yb + (size_t)s1_ * D) + F.lane; \
        _Pragma("unroll") for (int j = 0; j < 8; ++j) { nx[j] = *(const f32x4*)(xr_ + 4 * F.lane + 256 * j); ny0[j] = y0_[64 * j]; ny1[j] = y1_[64 * j]; } } while (0)
    if (gw < T) P10_LOAD(gw);
    for (int row = gw; row < T; row += NGW) {
        f32x4 v[8]; float s = 0.f; const float w0 = nw0, w1 = nw1;
#pragma unroll
        for (int j = 0; j < 8; ++j) { const v2u a0 = ny0[j], a1 = ny1[j];
            f32x4 m; m.x = w0 * bflo(a0.x) + w1 * bflo(a1.x); m.y = w0 * bfhi(a0.x) + w1 * bfhi(a1.x); m.z = w0 * bflo(a0.y) + w1 * bflo(a1.y); m.w = w0 * bfhi(a0.y) + w1 * bfhi(a1.y);
            v[j] = nx[j] + gv[j] * m; s += (v[j].x * v[j].x + v[j].y * v[j].y) + (v[j].z * v[j].z + v[j].w * v[j].w); }
        if (row + NGW < T) P10_LOAD(row + NGW);
        const float rstd = (1.f + dbg) / sqrtf(wave_sum(s) * (1.f / D) + EPS);
        float* xr = a.out + (size_t)row * D;
#pragma unroll
        for (int j = 0; j < 8; ++j) *(f32x4*)(xr + 4 * F.lane + 256 * j) = v[j] * rstd * fv[j];
    }
#undef P10_LOAD
}

constexpr int NPHASES = 12;
__global__ void __launch_bounds__(NTHR, 2) mk_fwd(Args args) {
    extern __shared__ __attribute__((aligned(16))) unsigned char lds_raw[];
    Frame F;
    F.lds = (LAS unsigned char*)lds_raw;
    F.tid = threadIdx.x; F.lane = F.tid & 63; F.wave = __builtin_amdgcn_readfirstlane(F.tid >> 6);
    F.G = gridDim.x; F.bid = blockIdx.x; F.vcu = (F.G % 8 == 0) ? (F.bid % 8) * (F.G / 8) + F.bid / 8 : F.bid;
    F.ws = args.ws;
    volatile LAS unsigned* MISC = (volatile LAS unsigned*)(F.lds + MISC_OFF);
    if (F.tid < 16) MISC[F.tid] = 0u;
    __syncthreads();
    const int lo = args.ph_lo, hi = args.ph_hi;
    XcdBarrier bar; bar.bar = (unsigned*)(F.ws + WS_CTL) + CW_BAR + args.li * XCD_BAR_WORDS; bar.x = 0; bar.st = nullptr;
    if (hi - lo > 1) bar = xcd_barrier_post((unsigned*)(F.ws + WS_CTL) + CW_BAR + args.li * XCD_BAR_WORDS, MISC + 8);
#define IN(k) (lo <= (k) && (k) < hi)
#define SEAM(k) do { if (IN(k) && IN((k) + 1)) xcd_barrier(bar); } while (0)
    float* mod = (float*)(F.ws + WS_MOD);

    if (IN(0)) { p0_ada(F, args.in[IN_C], args.in[IN_WADA], args.in[IN_BADA], mod); p0_convert(F, args); }
    SEAM(0);
    if (IN(1)) { norm_rows(F, args.in[IN_X], args.in[IN_N1W], mod + D, mod, (bf16*)(F.ws + WS_H)); p1_router_prep(F, args); }
    SEAM(1);
    if (IN(2)) {
        pg8::Gemm g{(const pg8::bf16_t*)(F.ws + WS_H), (const pg8::bf16_t*)(F.ws + WS_WIN), T, N_IN_PAD, D, 0}; ConvOrder S; S.init(T, N_IN_PAD, F.G, F.bid);
        S.J = ConvJob{args.in[IN_WG], args.in[IN_WU], args.in[IN_WD], (bf16*)(F.ws + WS_WGU), (bf16*)(F.ws + WS_WD)};
        const int nmy = (S.nwg - F.bid + F.G - 1) / F.G, gwv = F.bid * NWAVES + F.wave, per = 65536 / (F.G * NWAVES);
        S.pos = nmy > 0 ? (((F.bid >> 3) % 5) < nmy ? ((F.bid >> 3) % 5) : nmy - 1) : -1; S.it0 = gwv * per; S.nit = per;
        pg8::EpiU E{(pg8::bf16_t*)(F.ws + WS_U), (float*)(F.ws + WS_UDT)};
        pg8::gemm_phase<pg8::EpiU, ConvOrder, true, true>(F.lds, g, S, E);
    }
    SEAM(2);
    if (IN(3)) { for (int c = F.bid; c < NCHUNK; c += F.G) p3_chunk(F, args, c); }
    SEAM(3);
    if (IN(4)) p_scan(F);
    SEAM(4);
    if (IN(5)) { for (int u = F.bid; u < 2 * NCHUNK; u += F.G) p4_unit(F, args, u >> 1, u & 1); }
    SEAM(5);
    if (IN(6)) {
        pg8::Gemm g{(const pg8::bf16_t*)(F.ws + WS_YMIX), (const pg8::bf16_t*)(F.ws + WS_WOUT), T, D, D, 0}; ConvOrder S; S.init(T, D, F.G, F.bid);
        S.J = ConvJob{args.in[IN_WG], args.in[IN_WU], args.in[IN_WD], (bf16*)(F.ws + WS_WGU), (bf16*)(F.ws + WS_WD)};
        const int nmy = (S.nwg - F.bid + F.G - 1) / F.G, gwv = F.bid * NWAVES + F.wave, per = 32768 / (F.G * NWAVES);
        S.pos = nmy > 0 ? (((F.bid >> 3) & 1) < nmy ? ((F.bid >> 3) & 1) : nmy - 1) : -1; S.it0 = 65536 + gwv * per; S.nit = per;
        pg8::EpiX1 E{args.in[IN_X], args.out, mod + 2 * D};
        pg8::gemm_phase<pg8::EpiX1, ConvOrder, true, true>(F.lds, g, S, E);
    }
    SEAM(6);
    if (IN(7)) { for (int u = F.bid; u < NCHUNK; u += F.G) p6_unit(F, args, u); }
    SEAM(7);
    if (IN(8)) { for (int u = F.bid; u < NCHUNK; u += F.G) p7_unit(F, u); }
    SEAM(8);
    if (IN(9)) {
        const int ntiles = __builtin_amdgcn_readfirstlane(__hip_atomic_load((int*)(F.ws + WS_TILE) + 192, __ATOMIC_RELAXED, __HIP_MEMORY_SCOPE_AGENT));
        pg8::Gemm g{(const pg8::bf16_t*)(F.ws + WS_U), (const pg8::bf16_t*)(F.ws + WS_WGU), ntiles * 256, 2048, D, (size_t)2048 * D * 2};
        pg8::MoeOrder S{(const int*)(F.ws + WS_TILE), ntiles * 8, 8, F.G, F.vcu};
        pg8::EpiHid E{(pg8::bf16_t*)(F.ws + WS_YMIX)};
        pg8::gemm_phase<pg8::EpiHid, pg8::MoeOrder, true, true, true>(F.lds, g, S, E);
    }
    SEAM(9);
    if (IN(10)) {
        const int ntiles = __builtin_amdgcn_readfirstlane(__hip_atomic_load((int*)(F.ws + WS_TILE) + 192, __ATOMIC_RELAXED, __HIP_MEMORY_SCOPE_AGENT));
        pg8::Gemm g{(const pg8::bf16_t*)(F.ws + WS_YMIX), (const pg8::bf16_t*)(F.ws + WS_WD), ntiles * 256, 2048, FF, (size_t)2048 * FF * 2};
        pg8::MoeOrder S{(const int*)(F.ws + WS_TILE), ntiles * 8, 8, F.G, F.vcu};
        pg8::EpiY E{(pg8::bf16_t*)(F.ws + WS_YB)};
        pg8::gemm_phase<pg8::EpiY, pg8::MoeOrder, true, true, true>(F.lds, g, S, E);
    }
    SEAM(10);
    if (IN(11)) p10_rows(F, args);
#undef IN
#undef SEAM
}

extern "C" void kernel_launch(void* const* d_in, const int* in_sizes, int n_in, void* d_out, int out_size, void* d_ws, size_t ws_size, hipStream_t stream) {
    static int grid = 0;
    if (grid == 0) {
        if (n_in != N_INPUTS || in_sizes[0] != T * D || out_size != T * D || ws_size < WS_END) { fprintf(stderr, "kernel_launch: unexpected shapes (n_in %d, in0 %d, out %d, ws %zu < %zu); nothing launched\n", n_in, n_in > 0 ? in_sizes[0] : -1, out_size, ws_size, (size_t)WS_END); grid = -1; return; }
        int dev = 0, cus = 0, per_cu = 0;
        if (hipGetDevice(&dev) != hipSuccess || hipDeviceGetAttribute(&cus, hipDeviceAttributeMultiprocessorCount, dev) != hipSuccess) { fprintf(stderr, "kernel_launch: device query failed\n"); grid = -1; return; }
        if (hipFuncSetAttribute((const void*)mk_fwd, hipFuncAttributeMaxDynamicSharedMemorySize, LDS_BYTES) != hipSuccess) { fprintf(stderr, "kernel_launch: hipFuncSetAttribute failed\n"); grid = -1; return; }
        if (hipOccupancyMaxActiveBlocksPerMultiprocessor(&per_cu, (const void*)mk_fwd, NTHR, LDS_BYTES) != hipSuccess || per_cu < 1) fprintf(stderr, "kernel_launch: note: occupancy query reports %d workgroups per CU\n", per_cu);
        (void)hipGetLastError();
        grid = cus;
    }
    if (grid < 0) return;
    if (hipMemsetAsync((char*)d_ws + WS_CTL, 0, CTL_ZERO_BYTES, stream) != hipSuccess) { fprintf(stderr, "kernel_launch: memset failed\n"); return; }
    Args a{};
    for (int i = 0; i < N_INPUTS; ++i) a.in[i] = (const float*)d_in[i];
    a.out = (float*)d_out; a.ws = (unsigned char*)d_ws;
#if defined(MK_PROBE) && MK_PROBE == 1
    static const int cuts[][2] = {{0, 1}, {0, 12}};
#elif defined(MK_PROBE) && MK_PROBE == 2
    static const int cuts[][2] = {{0, 3}, {1, 12}};
#elif defined(MK_PROBE) && MK_PROBE == 3
    static const int cuts[][2] = {{0, 6}, {3, 12}};
#elif defined(MK_PROBE) && MK_PROBE == 4
    static const int cuts[][2] = {{0, 8}, {6, 12}};
#elif defined(MK_PROBE) && MK_PROBE == 5
    static const int cuts[][2] = {{0, 11}, {9, 12}};
#elif defined(MK_PROBE) && MK_PROBE == 6
    static const int cuts[][2] = {{0, 4}, {3, 12}};
#elif defined(MK_PROBE) && MK_PROBE == 7
    static const int cuts[][2] = {{0, 6}, {5, 12}};
#elif defined(MK_PROBE) && MK_PROBE == 8
    static const int cuts[][2] = {{0, 8}, {7, 12}};
#elif defined(MK_PROBE) && MK_PROBE == 9
    static const int cuts[][2] = {{0, 7}, {6, 12}};
#elif defined(MK_PROBE) && MK_PROBE == 10
    static const int cuts[][2] = {{0, 9}, {8, 12}};
#elif defined(MK_PROBE) && MK_PROBE == 11
    static const int cuts[][2] = {{0, 5}, {12, 12}, {4, 12}};
#elif MK_N_LAUNCHES == 1
    static const int cuts[][2] = {{0, NPHASES}};
#else
    static const int cuts[][2] = {{0, 1}, {1, 2}, {2, 3}, {3, 4}, {4, 5}, {5, 6}, {6, 7}, {7, 8}, {8, 9}, {9, 10}, {10, 11}, {11, 12}};
#endif
    for (int li = 0; li < (int)(sizeof(cuts) / sizeof(cuts[0])); ++li) { a.ph_lo = cuts[li][0]; a.ph_hi = cuts[li][1]; a.li = li; hipLaunchKernelGGL(mk_fwd, dim3(grid), dim3(NTHR), LDS_BYTES, stream, a); }
    const hipError_t le = hipPeekAtLastError();
    if (le != hipSuccess) fprintf(stderr, "kernel_launch: launch failed: %s\n", hipGetErrorName(le));
}
```

```cpp
#include <hip/hip_runtime.h>
#include <cstdio>
#include <cstdint>

#ifndef MK_N_LAUNCHES
#define MK_N_LAUNCHES 1
#endif

namespace pg8 {
#define PG8_LAS __attribute__((address_space(3)))
typedef unsigned short bf16_t;
typedef short bf16x8 __attribute__((ext_vector_type(8)));
typedef float f32x4 __attribute__((ext_vector_type(4)));
typedef unsigned u32x4 __attribute__((ext_vector_type(4)));
constexpr int BM = 256, BK = 64, HALF = 128, HTB = HALF * BK * 2  , STAGE_BYTES = 8 * HTB, NXCD = 8, WGM = 8;

__host__ __device__ __forceinline__ int lds_byte(int r, int c) { const int st = (r >> 4) * 2 + (c >> 5), rr = r & 15, cc = c & 31, ob = rr * 64 + cc * 2; return st * 1024 + (ob ^ (((ob >> 9) & 1) << 5)); }
__host__ __device__ __forceinline__ void stage_rc(int b, int& R, int& C) { const int st = b / 1024, sb = b % 1024, swz = sb ^ (((sb >> 9) & 1) << 5); R = (st >> 1) * 16 + swz / 64; C = (st & 1) * 32 + (swz % 64) / 2; }
__host__ __device__ __forceinline__ int perm32(int rho) { const int n = rho >> 4, i = rho & 15; return 8 * (i >> 2) + 4 * n + (i & 3); }

struct Unit { int pm, pn, pb, pe; };
struct Gemm { const bf16_t* A; const bf16_t* Bt; int M, N, K; size_t estep; };

struct StaticOrder {
    int nM, nN, nwg, G, c;
    __host__ __device__ void init(int M, int N, int G_, int c_) { nM = M / BM; nN = N / BM; nwg = nM * nN; G = G_; c = c_; }
    __host__ __device__ bool next(int i, Unit& u) const {
        const long L = (long)i * G + c; if (L >= nwg) return false;
        int wgid = (int)L; { const int q = nwg / NXCD, r = nwg % NXCD, xcd = wgid % NXCD, off = wgid / NXCD; wgid = (xcd < r ? xcd * (q + 1) : r * (q + 1) + (xcd - r) * q) + off; }
        const int nig = WGM * nN, gid = wgid / nig, fm = gid * WGM, gsz = (nM - fm) < WGM ? (nM - fm) : WGM;
        u.pm = fm + ((wgid % nig) % gsz); u.pn = (wgid % nig) / gsz; u.pb = u.pn; u.pe = 0; return true;
    }
    __device__ __forceinline__ void a_ready(const Unit&) const {}
    __device__ __forceinline__ void done(const Unit&, int) const {}
};
struct MoeOrder {
    const int* tile_e; int nunits, ncol, G, c;
    __device__ bool next(int i, Unit& u) const {
        const long L = (long)i * G + c; if (L >= nunits) return false;
        u.pm = (int)L / ncol; u.pn = (int)L % ncol;
        const int e = __builtin_amdgcn_readfirstlane(__hip_atomic_load((int*)tile_e + u.pm, __ATOMIC_RELAXED, __HIP_MEMORY_SCOPE_AGENT));
        u.pb = u.pn; u.pe = e; return true;
    }
    __device__ __forceinline__ void a_ready(const Unit&) const {}
    __device__ __forceinline__ void done(const Unit&, int) const {}
};

typedef float f32x2_t __attribute__((ext_vector_type(2)));
typedef __bf16 bf16x2_t __attribute__((ext_vector_type(2)));
__device__ __forceinline__ unsigned cvt_pk_bf16(float lo, float hi) { const f32x2_t v = {lo, hi}; const bf16x2_t b = __builtin_convertvector(v, bf16x2_t); return __builtin_bit_cast(unsigned, b); }

struct EpiU {
    static constexpr bool PERM = true, AFTER_DRAIN = false;
    bf16_t* U; float* udt;
    __device__ __forceinline__ void operator()(const f32x4 (&acc)[2][2][4][2], const Unit& u, int wr, int wc, int fr, int fq) const {
        const int row0 = u.pm * BM + wr * 64 + fr;
        if (u.pn < 22) {
            const int col0 = u.pn * BM + wc * 32 + 8 * fq;
#pragma unroll
            for (int ai = 0; ai < 2; ++ai)
#pragma unroll
                for (int m = 0; m < 4; ++m) { bf16_t* rowp = U + (size_t)(row0 + ai * HALF + m * 16) * 5632 + col0;
#pragma unroll
                    for (int bj = 0; bj < 2; ++bj) { const f32x4 v0 = acc[ai][bj][m][0], v1 = acc[ai][bj][m][1];
                        u32x4 w; w.x = cvt_pk_bf16(v0[0], v0[1]); w.y = cvt_pk_bf16(v0[2], v0[3]); w.z = cvt_pk_bf16(v1[0], v1[1]); w.w = cvt_pk_bf16(v1[2], v1[3]);
                        *(u32x4*)(rowp + bj * HALF) = w; } }
        } else if (wc == 0 && fq < 2) {
#pragma unroll
            for (int ai = 0; ai < 2; ++ai)
#pragma unroll
                for (int m = 0; m < 4; ++m) { float* rowp = udt + (size_t)(row0 + ai * HALF + m * 16) * 16 + 8 * fq;
                    *(f32x4*)(rowp) = acc[ai][0][m][0]; *(f32x4*)(rowp + 4) = acc[ai][0][m][1]; }
        }
    }
};
struct EpiX1 {
    static constexpr bool PERM = false, AFTER_DRAIN = false;
    const float* X; float* O; const float* gate;
    __device__ __forceinline__ void operator()(const f32x4 (&acc)[2][2][4][2], const Unit& u, int wr, int wc, int fr, int fq) const {
        const int row0 = u.pm * BM + wr * 64 + fr, col0 = u.pn * BM + wc * 32 + 4 * fq;
        f32x4 gv[2][2];
#pragma unroll
        for (int bj = 0; bj < 2; ++bj)
#pragma unroll
            for (int n = 0; n < 2; ++n) gv[bj][n] = *(const f32x4*)(gate + col0 + bj * HALF + n * 16);
#pragma unroll
        for (int ai = 0; ai < 2; ++ai)
#pragma unroll
            for (int m = 0; m < 4; ++m) { const size_t ro = (size_t)(row0 + ai * HALF + m * 16) * 2048 + col0;
#pragma unroll
                for (int bj = 0; bj < 2; ++bj)
#pragma unroll
                    for (int n = 0; n < 2; ++n) { const f32x4 xv = *(const f32x4*)(X + ro + bj * HALF + n * 16);
                        *(f32x4*)(O + ro + bj * HALF + n * 16) = xv + gv[bj][n] * acc[ai][bj][m][n]; } }
    }
};
struct EpiHid {
    static constexpr bool PERM = true, AFTER_DRAIN = false;
    bf16_t* Hd;
    __device__ __forceinline__ void operator()(const f32x4 (&acc)[2][2][4][2], const Unit& u, int wr, int wc, int fr, int fq) const {
        const int row0 = u.pm * BM + wr * 64 + fr, col0 = u.pn * HALF + wc * 32 + 8 * fq;
#pragma unroll
        for (int ai = 0; ai < 2; ++ai)
#pragma unroll
            for (int m = 0; m < 4; ++m) { bf16_t* rowp = Hd + (size_t)(row0 + ai * HALF + m * 16) * 1024 + col0;
                float r[8];
#pragma unroll
                for (int n = 0; n < 2; ++n)
#pragma unroll
                    for (int j = 0; j < 4; ++j) { const float g = acc[ai][0][m][n][j], up = acc[ai][1][m][n][j]; r[4 * n + j] = g / (1.f + __expf(-g)) * up; }
                u32x4 w; w.x = cvt_pk_bf16(r[0], r[1]); w.y = cvt_pk_bf16(r[2], r[3]); w.z = cvt_pk_bf16(r[4], r[5]); w.w = cvt_pk_bf16(r[6], r[7]);
                *(u32x4*)(rowp) = w; }
    }
};
struct EpiY {
    static constexpr bool PERM = true, AFTER_DRAIN = false;
    bf16_t* Y;
    __device__ __forceinline__ void operator()(const f32x4 (&acc)[2][2][4][2], const Unit& u, int wr, int wc, int fr, int fq) const {
        const int row0 = u.pm * BM + wr * 64 + fr, col0 = u.pn * BM + wc * 32 + 8 * fq;
#pragma unroll
        for (int ai = 0; ai < 2; ++ai)
#pragma unroll
            for (int m = 0; m < 4; ++m) { bf16_t* rowp = Y + (size_t)(row0 + ai * HALF + m * 16) * 2048 + col0;
#pragma unroll
                for (int bj = 0; bj < 2; ++bj) { const f32x4 v0 = acc[ai][bj][m][0], v1 = acc[ai][bj][m][1];
                    u32x4 w; w.x = cvt_pk_bf16(v0[0], v0[1]); w.y = cvt_pk_bf16(v0[2], v0[3]); w.z = cvt_pk_bf16(v1[0], v1[1]); w.w = cvt_pk_bf16(v1[2], v1[3]);
                    *(u32x4*)(rowp + bj * HALF) = w; } }
    }
};

template <class Epi, class Sched, bool ALIGN_EPI = false, bool SP2 = false, bool BK8 = false>
__device__ __forceinline__ void gemm_phase(PG8_LAS unsigned char* lds, const Gemm g, const Sched& S, const Epi& E) {
    const int tid = threadIdx.x, wid = __builtin_amdgcn_readfirstlane(tid >> 6), lane = tid & 63, wr = wid >> 2, wc = wid & 3, fr = lane & 15, fq = lane >> 4;
    const int K = g.K, nt = K / BK;
    unsigned voffA[2], voffB[2];
#pragma unroll
    for (int i = 0; i < 2; ++i) { int R, C; stage_rc(tid * 16 + i * 8192, R, C); const int Rb = Epi::PERM ? ((R & ~31) + perm32(R & 31)) : R;
        voffA[i] = (unsigned)(R * K + C) * 2u; voffB[i] = BK8 ? (unsigned)((C >> 3) * g.N + Rb) * 16u : (unsigned)(Rb * K + C) * 2u; }
    const size_t kstepA = (size_t)(BK * 2), hstepA = (size_t)HALF * K * 2, tstepA = 2 * hstepA;
    const size_t kstepB = BK8 ? (size_t)128 * g.N : (size_t)(BK * 2), hstepB = BK8 ? (size_t)2048 : (size_t)HALF * K * 2;
#define PG8_BBASE(u) ((const char*)g.Bt + (BK8 ? (size_t)(u).pe * g.estep + (size_t)(u).pb * 4096 : (size_t)(u).pb * 2 * hstepB))
    const unsigned ldsw = (unsigned)wid * 1024u;
    const int aoff = lds_byte(wr * 64 + fr, fq * 8), boff = lds_byte(wc * 32 + fr, fq * 8);
#define PG8_SA(b, h) (((b) * 2 + (h)) * HTB)
#define PG8_SB(b, h) ((4 + (b) * 2 + (h)) * HTB)
#define PG8_STAGE(bufoff, gbase, voff) do { _Pragma("unroll") for (int _i = 0; _i < 2; ++_i) \
        __builtin_amdgcn_global_load_lds((const unsigned*)((const char*)(gbase) + (voff)[_i]), (PG8_LAS unsigned*)(lds + (bufoff) + ldsw + _i * 8192), 16, 0, 0); } while (0)
#define PG8_LDA(dst, b, h) do { _Pragma("unroll") for (int m = 0; m < 4; ++m) _Pragma("unroll") for (int k = 0; k < 2; ++k) dst[m][k] = *(const PG8_LAS bf16x8*)(lds + PG8_SA(b, h) + aoff + m * 2048 + k * 1024); } while (0)
#define PG8_LDB(dst, b, h) do { _Pragma("unroll") for (int n = 0; n < 2; ++n) _Pragma("unroll") for (int k = 0; k < 2; ++k) dst[n][k] = *(const PG8_LAS bf16x8*)(lds + PG8_SB(b, h) + boff + n * 2048 + k * 1024); } while (0)
#define PG8_MMA(ai, bj, At, Bt) do { __builtin_amdgcn_s_setprio(1); _Pragma("unroll") for (int m = 0; m < 4; ++m) _Pragma("unroll") for (int n = 0; n < 2; ++n) _Pragma("unroll") for (int k = 0; k < 2; ++k) \
        acc[ai][bj][m][n] = __builtin_amdgcn_mfma_f32_16x16x32_bf16(Bt[n][k], At[m][k], acc[ai][bj][m][n], 0, 0, 0); __builtin_amdgcn_s_setprio(0); } while (0)
#define PG8_WAIT_V(n) asm volatile("s_waitcnt vmcnt(" #n ")" ::: "memory")
#define PG8_WAIT_L(n) asm volatile("s_waitcnt lgkmcnt(" #n ")" ::: "memory")
#define PG8_BAR __builtin_amdgcn_s_barrier()
#define PG8_SCHED __builtin_amdgcn_sched_barrier(0)
    Unit cur, nxt; int ui = 0;
    if (!S.next(0, cur)) return;
    f32x4 acc[2][2][4][2];
#pragma unroll
    for (int a = 0; a < 2; ++a)
#pragma unroll
        for (int b = 0; b < 2; ++b)
#pragma unroll
            for (int m = 0; m < 4; ++m)
#pragma unroll
                for (int n = 0; n < 2; ++n) acc[a][b][m][n] = (f32x4){0.f, 0.f, 0.f, 0.f};
    bf16x8 At[4][2], B0[2][2], B1[2][2];
    const char* cA = (const char*)g.A + (size_t)cur.pm * tstepA; const char* cB = PG8_BBASE(cur);
    S.a_ready(cur);
    if constexpr (SP2) {
        PG8_STAGE(PG8_SB(0, 0), cB, voffB); PG8_STAGE(PG8_SB(0, 1), cB + hstepB, voffB); PG8_STAGE(PG8_SA(0, 0), cA, voffA); PG8_STAGE(PG8_SA(0, 1), cA + hstepA, voffA);
        if (wr == 1) PG8_BAR;
        PG8_WAIT_V(2); PG8_BAR;
        PG8_STAGE(PG8_SB(1, 0), cB + kstepB, voffB); PG8_STAGE(PG8_SA(1, 0), cA + kstepA, voffA); PG8_STAGE(PG8_SB(1, 1), cB + hstepB + kstepB, voffB);
        PG8_WAIT_V(6); PG8_BAR;
    } else {
        PG8_STAGE(PG8_SB(0, 0), cB, voffB); PG8_STAGE(PG8_SA(0, 0), cA, voffA); PG8_STAGE(PG8_SB(0, 1), cB + hstepB, voffB); PG8_STAGE(PG8_SA(0, 1), cA + hstepA, voffA);
        if (wr == 1) PG8_BAR;
        PG8_WAIT_V(4); PG8_BAR;
        PG8_STAGE(PG8_SB(1, 0), cB + kstepB, voffB); PG8_STAGE(PG8_SA(1, 0), cA + kstepA, voffA); PG8_STAGE(PG8_SB(1, 1), cB + hstepB + kstepB, voffB);
        PG8_WAIT_V(6); PG8_BAR;
    }
    for (;;) {
        const bool has_next = S.next(ui + 1, nxt);
        const char* nA = has_next ? (const char*)g.A + (size_t)nxt.pm * tstepA : cA; const char* nB = has_next ? PG8_BBASE(nxt) : cB;
        for (int t = 0; t < nt; t += 2) {
            const bool last = (t == nt - 2);
            const char* a1 = cA + (size_t)(t + 1) * kstepA;
            const char* a2 = last ? nA : cA + (size_t)(t + 2) * kstepA; const char* b2 = last ? nB : cB + (size_t)(t + 2) * kstepB;
            const char* a3 = a2 + kstepA; const char* b3 = b2 + kstepB;
            if (last && has_next) S.a_ready(nxt);
            if constexpr (SP2) {
            PG8_LDB(B0, 0, 0); PG8_LDB(B1, 0, 1); PG8_SCHED; PG8_LDA(At, 0, 0); PG8_STAGE(PG8_SA(1, 1), a1 + hstepA, voffA);
            PG8_WAIT_V(8); PG8_WAIT_L(0); PG8_BAR; PG8_MMA(0, 0, At, B0); PG8_MMA(0, 1, At, B1); PG8_BAR; PG8_SCHED;
            PG8_LDA(At, 0, 1); PG8_STAGE(PG8_SB(0, 0), b2, voffB); PG8_STAGE(PG8_SB(0, 1), b2 + hstepB, voffB); PG8_STAGE(PG8_SA(0, 0), a2, voffA);
            PG8_WAIT_V(8); PG8_WAIT_L(0); PG8_BAR; PG8_MMA(1, 0, At, B0); PG8_MMA(1, 1, At, B1); PG8_BAR; PG8_SCHED;
            PG8_LDB(B0, 1, 0); PG8_LDB(B1, 1, 1); PG8_SCHED; PG8_LDA(At, 1, 0); PG8_STAGE(PG8_SA(0, 1), a2 + hstepA, voffA);
            PG8_WAIT_V(8); PG8_WAIT_L(0); PG8_BAR; PG8_MMA(0, 0, At, B0); PG8_MMA(0, 1, At, B1); PG8_BAR; PG8_SCHED;
            PG8_LDA(At, 1, 1); PG8_STAGE(PG8_SB(1, 0), b3, voffB); PG8_STAGE(PG8_SB(1, 1), b3 + hstepB, voffB); PG8_STAGE(PG8_SA(1, 0), a3, voffA);
            PG8_WAIT_V(8); PG8_WAIT_L(0); PG8_BAR; PG8_MMA(1, 0, At, B0); PG8_MMA(1, 1, At, B1); PG8_BAR; PG8_SCHED;
            } else {
            PG8_LDB(B0, 0, 0); PG8_SCHED; PG8_LDA(At, 0, 0); PG8_STAGE(PG8_SA(1, 1), a1 + hstepA, voffA);
            PG8_WAIT_L(8); PG8_BAR; PG8_WAIT_L(0); PG8_MMA(0, 0, At, B0); PG8_BAR; PG8_SCHED;
            PG8_LDB(B1, 0, 1); PG8_STAGE(PG8_SB(0, 0), b2, voffB);
            PG8_BAR; PG8_WAIT_L(0); PG8_MMA(0, 1, At, B1); PG8_BAR;
            PG8_LDA(At, 0, 1); PG8_STAGE(PG8_SA(0, 0), a2, voffA);
            PG8_BAR; PG8_WAIT_L(0); PG8_MMA(1, 0, At, B0); PG8_BAR; PG8_SCHED;
            PG8_STAGE(PG8_SB(0, 1), b2 + hstepB, voffB);
            PG8_WAIT_V(6); PG8_BAR; PG8_MMA(1, 1, At, B1); PG8_BAR;
            PG8_LDB(B0, 1, 0); PG8_SCHED; PG8_LDA(At, 1, 0); PG8_STAGE(PG8_SA(0, 1), a2 + hstepA, voffA);
            PG8_WAIT_L(8); PG8_BAR; PG8_WAIT_L(0); PG8_MMA(0, 0, At, B0); PG8_BAR; PG8_SCHED;
            PG8_LDB(B1, 1, 1); PG8_STAGE(PG8_SB(1, 0), b3, voffB);
            PG8_BAR; PG8_WAIT_L(0); PG8_MMA(0, 1, At, B1); PG8_BAR;
            PG8_LDA(At, 1, 1); PG8_STAGE(PG8_SA(1, 0), a3, voffA);
            PG8_BAR; PG8_WAIT_L(0); PG8_MMA(1, 0, At, B0); PG8_BAR; PG8_SCHED;
            PG8_STAGE(PG8_SB(1, 1), b3 + hstepB, voffB);
            PG8_WAIT_V(6); PG8_BAR; PG8_MMA(1, 1, At, B1); PG8_BAR;
            }
        }
        if constexpr (ALIGN_EPI) { if (wr == 0) PG8_BAR; }
        if constexpr (!Epi::AFTER_DRAIN) { E(acc, cur, wr, wc, fr, fq); S.done(cur, ui); }
        if (!has_next) break;
#pragma unroll
        for (int a = 0; a < 2; ++a)
#pragma unroll
            for (int b = 0; b < 2; ++b)
#pragma unroll
                for (int m = 0; m < 4; ++m)
#pragma unroll
                    for (int n = 0; n < 2; ++n) acc[a][b][m][n] = (f32x4){0.f, 0.f, 0.f, 0.f};
        cur = nxt; cA = nA; cB = nB; ++ui;
        if constexpr (ALIGN_EPI) { if (wr == 1) PG8_BAR; }
    }
    PG8_WAIT_V(0);
    if constexpr (!ALIGN_EPI) { if (wr == 0) PG8_BAR; }
    PG8_BAR;
    if constexpr (Epi::AFTER_DRAIN) { E.fused(acc, cur, wr, wc, fr, fq, lds, wid, lane); S.done(cur, ui); }
#undef PG8_BBASE
#undef PG8_SA
#undef PG8_SB
#undef PG8_STAGE
#undef PG8_LDA
#undef PG8_LDB
#undef PG8_MMA
#undef PG8_WAIT_V
#undef PG8_WAIT_L
#undef PG8_BAR
#undef PG8_SCHED
}
}
#define XB_TMO      128
#define XB_XCNT(j)  (256  + 64 * (j))
#define XB_XSUB(j)  (1280 + 64 * (j))
#define XB_XGEN(j)  (2304 + 64 * (j))
#define XB_TOP      3328
#define XB_TOPGEN   3392
#define XCD_BAR_WORDS 3456
#define XB_SPIN_CAP (1u << 18)
#define LAS __attribute__((address_space(3)))

__device__ __forceinline__ unsigned xb_ld(unsigned* p)              { return __hip_atomic_load(p, __ATOMIC_RELAXED, __HIP_MEMORY_SCOPE_AGENT); }
__device__ __forceinline__ unsigned xb_add(unsigned* p, unsigned v) { return __hip_atomic_fetch_add(p, v, __ATOMIC_RELAXED, __HIP_MEMORY_SCOPE_AGENT); }
__device__ __forceinline__ unsigned xb_xcc_id() { return (unsigned)__builtin_amdgcn_s_getreg((3 << 11) | 20) & 0xFu; }
#define XB_SPIN(cond, bar) do { unsigned _sp = 0; while (cond) { __builtin_amdgcn_s_sleep(1); \
    if ((++_sp & 255u) == 0u) { if (xb_ld(&(bar)[XB_TMO])) break; if (_sp > XB_SPIN_CAP) { atomicAdd(&(bar)[XB_TMO], 1u); break; } } } } while (0)

struct XcdBarrier {
    unsigned* bar; unsigned x;
    volatile LAS unsigned* st;
};

__device__ __forceinline__ XcdBarrier xcd_barrier_post(unsigned* bar, volatile LAS unsigned* st) {
    XcdBarrier b; b.bar = bar; b.x = xb_xcc_id(); b.st = st;
    if (threadIdx.x == 0) (void)xb_add(&bar[XB_XCNT(b.x)], 1u);
    return b;
}
__device__ __forceinline__ void xcd_barrier_complete(unsigned* bar, unsigned x, unsigned& nloc, unsigned& nx) {
    const unsigned G = gridDim.x * gridDim.y * gridDim.z;
    unsigned sum, cnt, mine, sp = 0u;
    for (;;) {
        sum = 0u; cnt = 0u; mine = 0u;
#pragma unroll
        for (unsigned j = 0; j < 16; ++j) { const unsigned c = xb_ld(&bar[XB_XCNT(j)]); sum += c; cnt += (c > 0u) ? 1u : 0u; mine = (j == x) ? c : mine; }
        if (sum == G) break;
        __builtin_amdgcn_s_sleep(1);
        if ((++sp & 255u) == 0u) { if (xb_ld(&bar[XB_TMO])) break; if (sp > XB_SPIN_CAP) { atomicAdd(&bar[XB_TMO], 1u); break; } }
    }
    nloc = mine > 0u ? mine : 1u; nx = cnt > 0u ? cnt : 1u;
}

__device__ __forceinline__ void xcd_barrier(const XcdBarrier& b) {
    asm volatile("s_waitcnt vmcnt(0)" ::: "memory");
    __syncthreads();
    if (threadIdx.x == 0) {
        unsigned* bar = b.bar;
        __builtin_amdgcn_s_waitcnt(0);
        unsigned nloc = b.st[0], nx = b.st[1];
        if (nloc == 0u) { xcd_barrier_complete(bar, b.x, nloc, nx); b.st[0] = nloc; b.st[1] = nx; }
        const unsigned old = xb_add(&bar[XB_XSUB(b.x)], 1u);
        const unsigned gen = old / nloc;
        if (old + 1u == (gen + 1u) * nloc) {
            __builtin_amdgcn_fence(__ATOMIC_RELEASE, "agent");
            asm volatile("s_waitcnt vmcnt(0)" ::: "memory");
            const unsigned og = xb_add(&bar[XB_TOP], 1u);
            const unsigned tg = og / nx;
            if (og + 1u == (tg + 1u) * nx) xb_add(&bar[XB_TOPGEN], 1u);
            else XB_SPIN(xb_ld(&bar[XB_TOPGEN]) == tg, bar);
            __builtin_amdgcn_fence(__ATOMIC_ACQUIRE, "agent");
            xb_add(&bar[XB_XGEN(b.x)], 1u);
            asm volatile("s_waitcnt vmcnt(0)" ::: "memory");
        } else {
            XB_SPIN(xb_ld(&bar[XB_XGEN(b.x)]) == gen, bar);
            __builtin_amdgcn_fence(__ATOMIC_ACQUIRE, "agent");
            asm volatile("s_waitcnt vmcnt(0)" ::: "memory");
        }
    }
    __syncthreads();
}

constexpr int T = 16384, D = 2048, NTHR = 512, NWAVES = 8;
constexpr int NU = 5632;
constexpr int N_IN = 5648, N_IN_PAD = 5888;
constexpr int NCHUNK = 256;
constexpr int NE = 32, FF = 1024;
constexpr int MAX_TILES = 160;
constexpr float EPS = 1e-6f;
enum { IN_X = 0, IN_C, IN_WADA, IN_BADA, IN_N1W, IN_WIN, IN_CONVW, IN_SCONVW, IN_SCONVB, IN_DTB, IN_ALOG, IN_DSKIP, IN_SNW, IN_WOUT, IN_N2W, IN_WRG, IN_BRG, IN_WRE, IN_BRE, IN_WG, IN_WU, IN_WD, IN_FNW, N_INPUTS };

constexpr size_t KiB = 1024, MiB = 1u << 20;
constexpr size_t WS_CTL = 0, CTL_ZERO_BYTES = 1 * MiB;
constexpr size_t WS_MOD = 1 * MiB;
constexpr size_t WS_BIAS2 = 1 * MiB + 56 * KiB;
constexpr size_t WS_W2T = 1 * MiB + 64 * KiB;
constexpr size_t WS_BLKCNT = 1536 * KiB;
constexpr size_t WS_TILE = 1600 * KiB;
constexpr size_t WS_SLOT = 1664 * KiB;
constexpr size_t WS_EW = 1792 * KiB;
constexpr size_t WS_EID = 1920 * KiB;
constexpr size_t WS_RANK = 5 * MiB;
constexpr size_t WS_DT = 2 * MiB, WS_ACS = 3 * MiB, WS_UDT = 4 * MiB;
constexpr size_t WS_WIN = 8 * MiB;
constexpr size_t WS_WOUT = 32 * MiB;
constexpr size_t WS_WGU = 40 * MiB;
constexpr size_t WS_WD = 296 * MiB;
constexpr size_t WS_H = 424 * MiB;
constexpr size_t WS_U = 488 * MiB;
constexpr size_t WS_YMIX = 664 * MiB;
constexpr size_t WS_XS = 744 * MiB;
constexpr size_t WS_BM = 776 * MiB, WS_CM = 784 * MiB;
constexpr size_t WS_ST = 792 * MiB;
constexpr size_t WS_BMT = 856 * MiB;
constexpr size_t WS_YB = 744 * MiB;
constexpr size_t WS_END = 904 * MiB;
constexpr int CW_DBG = 16;
constexpr int CW_BAR = 4096;

constexpr int RING_BYTES = 131072;
constexpr int MISC_OFF = 131072;
constexpr int LDS_BYTES = 131072 + 1024;

#define GAS __attribute__((address_space(1)))
typedef unsigned short bf16;
typedef unsigned v4u __attribute__((ext_vector_type(4)));
typedef unsigned v2u __attribute__((ext_vector_type(2)));
typedef float f32x4 __attribute__((ext_vector_type(4)));
#define LDS_WAIT() asm volatile("s_waitcnt lgkmcnt(0)" ::: "memory")
__device__ __forceinline__ float bflo(unsigned u) { return __builtin_bit_cast(float, u << 16); }
__device__ __forceinline__ float bfhi(unsigned u) { return __builtin_bit_cast(float, u & 0xffff0000u); }
__device__ __forceinline__ unsigned pk2(float lo, float hi) { return pg8::cvt_pk_bf16(lo, hi); }
__device__ __forceinline__ float wave_sum(float v) {
#pragma unroll
    for (int o = 1; o < 64; o <<= 1) v += __shfl_xor(v, o);
    return v;
}
__device__ __forceinline__ float silu_f(float v) { return v / (1.f + __expf(-v)); }

struct Args { const float* in[N_INPUTS]; float* out; unsigned char* ws; int ph_lo, ph_hi, li, pad; };

struct Frame {
    LAS unsigned char* lds;
    int tid, lane, wave, G, vcu, bid;
    unsigned char* ws;
};

struct ConvJob { const float* wg; const float* wu; const float* wd; bf16* dgu; bf16* dd; };
struct K8Item { const float* src; bf16* dst; int ldw, rowadd, gate_like; };
__device__ __forceinline__ K8Item k8_decode(const ConvJob& J, int id, int lane) {
    K8Item t;
    if (id < 65536) { const int up = id >> 15, r0 = id & 32767, e = r0 >> 10, r = r0 & 1023, kb = r >> 2, nb = r & 3;
        t.src = (up ? J.wu : J.wg) + (size_t)e * D * FF + (size_t)(kb * 8) * FF + nb * 256 + lane; t.ldw = FF;
        t.dst = J.dgu + (size_t)e * 2048 * D + (size_t)kb * 2048 * 8; t.rowadd = (up ? 128 : 0) + nb * 512; t.gate_like = 1; }
    else { const int r0 = id - 65536, e = r0 >> 10, r = r0 & 1023, kb = r >> 3, nb = r & 7;
        t.src = J.wd + (size_t)e * FF * D + (size_t)(kb * 8) * D + nb * 256 + lane; t.ldw = D;
        t.dst = J.dd + (size_t)e * 2048 * FF + (size_t)kb * 2048 * 8; t.rowadd = nb * 256; t.gate_like = 0; }
    return t;
}
#define K8_LOAD(v, t, h) do { _Pragma("unroll") for (int g = 0; g < 2; ++g) _Pragma("unroll") for (int i = 0; i < 8; ++i) v[g][i] = (t).src[(size_t)i * (t).ldw + 64 * (2 * (h) + g)]; } while (0)
#define K8_STORE(v, t, h) do { _Pragma("unroll") for (int g = 0; g < 2; ++g) { const int c_ = 64 * (2 * (h) + g) + lane; const int row_ = (t).rowadd + ((t).gate_like ? ((c_ >> 7) << 8) + (c_ & 127) : c_); \
        v4u o_; o_.x = pk2(v[g][0], v[g][1]); o_.y = pk2(v[g][2], v[g][3]); o_.z = pk2(v[g][4], v[g][5]); o_.w = pk2(v[g][6], v[g][7]); *(v4u*)((t).dst + (size_t)row_ * 8) = o_; } } while (0)
__device__ __forceinline__ void k8_convert(const ConvJob& J, int it0, int nit, int lane) {
    if (nit <= 0) return;
    float va[2][8], vb[2][8];
    K8Item t = k8_decode(J, it0, lane);
    K8_LOAD(va, t, 0);
#pragma unroll 1
    for (int id = it0; id < it0 + nit; ++id) {
        K8_LOAD(vb, t, 1);
        K8_STORE(va, t, 0);
        const K8Item tn = k8_decode(J, (id + 1 < it0 + nit) ? id + 1 : id, lane);
        K8_LOAD(va, tn, 0);
        K8_STORE(vb, t, 1);
        t = tn;
    }
}
#undef K8_LOAD
#undef K8_STORE
struct ConvOrder : pg8::StaticOrder {
    ConvJob J; int pos, it0, nit;
    __device__ __forceinline__ void done(const pg8::Unit&, int ui) const { if (ui == pos) k8_convert(J, it0, nit, (int)(threadIdx.x & 63)); }
};

__device__ __forceinline__ void p0_ada(const Frame& F, const float* cvec, const float* w_ada, const float* b_ada, float* mod) {
    LAS float* red = (LAS float*)F.lds;
    const int kq = F.tid / 12, cq = F.tid % 12;
    for (int chunk = F.vcu; chunk < 256; chunk += F.G) {
        if (F.tid < 504) {
            f32x4 acc = (f32x4){0.f, 0.f, 0.f, 0.f};
            const float* wp = w_ada + 48 * chunk + 4 * cq;
#pragma unroll 7
            for (int i = 0; i < 49; ++i) {
                const int k = kq + 42 * i; const bool ok = k < D; const int kk = ok ? k : 0;
                const float cv = cvec[kk]; const float s = ok ? cv / (1.f + expf(-cv)) : 0.f;
                const f32x4 w = *(const f32x4*)(wp + (size_t)kk * 12288);
                acc += s * w;
            }
            *(LAS f32x4*)(red + kq * 48 + 4 * cq) = acc;
        }
        __syncthreads();
        if (F.tid < 48) { float s = 0.f; for (int q = 0; q < 42; ++q) s += red[q * 48 + F.tid]; mod[48 * chunk + F.tid] = s + b_ada[48 * chunk + F.tid]; }
        __syncthreads();
    }
}
__device__ __forceinline__ void tr_item(const float* W, int ldw, int nvalid, int k0, int n0, bf16* dst, int ldd, LAS float* scr, int lane) {
    const int nn = n0 + (lane & 31); const bool ok = nn < nvalid; const int nc = ok ? nn : 0;
#pragma unroll 8
    for (int i = 0; i < 32; ++i) { const int kk = 2 * i + (lane >> 5); const float v = W[(size_t)(k0 + kk) * ldw + nc]; scr[kk * 33 + (lane & 31)] = ok ? v : 0.f; }
    LDS_WAIT();
    const int c = lane & 7;
#pragma unroll
    for (int j = 0; j < 4; ++j) { const int n = (lane >> 3) + 8 * j; const LAS float* s = scr + (8 * c) * 33 + n;
        v4u o; o.x = pk2(s[0 * 33], s[1 * 33]); o.y = pk2(s[2 * 33], s[3 * 33]); o.z = pk2(s[4 * 33], s[5 * 33]); o.w = pk2(s[6 * 33], s[7 * 33]);
        *(v4u*)(dst + (size_t)n * ldd + k0 + 8 * c) = o; }
    LDS_WAIT();
}
__device__ __forceinline__ void p0_convert(const Frame& F, const Args& a) {
    LAS float* scr = (LAS float*)(F.lds + 16384 + F.wave * 8704);
    bf16* Wt_in = (bf16*)(F.ws + WS_WIN); bf16* Wt_out = (bf16*)(F.ws + WS_WOUT);
    constexpr int I_IN = 32 * 177, I_OUT = 32 * 64, NITEMS = I_IN + I_OUT;
    const int gw = F.bid * NWAVES + F.wave, NGW = F.G * NWAVES;
    for (int it = gw; it < NITEMS; it += NGW) {
        int r = it;
        if (r < I_IN) { const int kb = r / 177, nb = r % 177; tr_item(a.in[IN_WIN], N_IN, N_IN, 64 * kb, 32 * nb, Wt_in + (size_t)(32 * nb) * D, D, scr, F.lane); continue; } r -= I_IN;
        { const int kb = r / 64, nb = r % 64; tr_item(a.in[IN_WOUT], D, D, 64 * kb, 32 * nb, Wt_out + (size_t)(32 * nb) * D, D, scr, F.lane); }
    }
    v4u* z = (v4u*)(Wt_in + (size_t)5664 * D); const int nz = 224 * D * 2 / 16;
    for (int i = F.bid * NTHR + F.tid; i < nz; i += F.G * NTHR) z[i] = (v4u){0u, 0u, 0u, 0u};
}

__device__ __forceinline__ void norm_rows(const Frame& F, const float* X, const float* nw, const float* sc, const float* sh, bf16* H) {
    f32x4 av[8], sv[8];
#pragma unroll
    for (int j = 0; j < 8; ++j) { const int k = 4 * F.lane + 256 * j; const f32x4 w = *(const f32x4*)(nw + k), s = *(const f32x4*)(sc + k); av[j] = w * (s + 1.f); sv[j] = *(const f32x4*)(sh + k); }
    const int gw = F.bid * NWAVES + F.wave, NGW = F.G * NWAVES;
    f32x4 nx[8];
    if (gw < T) {
#pragma unroll
        for (int j = 0; j < 8; ++j) nx[j] = ((const f32x4*)(X + (size_t)gw * D) + F.lane)[64 * j]; }
    for (int row = gw; row < T; row += NGW) {
        f32x4 v[8]; float s = 0.f;
#pragma unroll
        for (int j = 0; j < 8; ++j) { v[j] = nx[j]; s += (v[j].x * v[j].x + v[j].y * v[j].y) + (v[j].z * v[j].z + v[j].w * v[j].w); }
        if (row + NGW < T) {
#pragma unroll
            for (int j = 0; j < 8; ++j) nx[j] = ((const f32x4*)(X + (size_t)(row + NGW) * D) + F.lane)[64 * j]; }
        const float rstd = 1.f / sqrtf(wave_sum(s) * (1.f / D) + EPS);
        v2u* o = (v2u*)(H + (size_t)row * D) + F.lane;
#pragma unroll
        for (int j = 0; j < 8; ++j) { const f32x4 h = v[j] * rstd * av[j] + sv[j]; v2u w; w.x = pk2(h.x, h.y); w.y = pk2(h.z, h.w); o[64 * j] = w; }
    }
}
__device__ __forceinline__ void p1_router_prep(const Frame& F, const Args& a) {
    const float* mod = (const float*)(F.ws + WS_MOD); const float* sh2 = mod + 3 * D; const float* sc2 = mod + 4 * D;
    float* w2t = (float*)(F.ws + WS_W2T); float* bias2 = (float*)(F.ws + WS_BIAS2);
    const float* wrg = a.in[IN_WRG]; const float* wre = a.in[IN_WRE]; const float* n2w = a.in[IN_N2W];
    for (int i = F.bid * NTHR + F.tid; i < 48 * D; i += F.G * NTHR) {
        const int c = i / D, k = i % D; float v = 0.f;
        if (c < 36) { const float w = c < 4 ? wrg[k * 4 + c] : wre[k * 32 + (c - 4)]; v = w * n2w[k] * (1.f + sc2[k]); }
        w2t[i] = v;
    }
    if (F.bid == 0) {
        for (int c = F.wave; c < 48; c += NWAVES) { float s = 0.f;
            if (c < 36) { for (int k = F.lane; k < D; k += 64) { const float w = c < 4 ? wrg[k * 4 + c] : wre[k * 32 + (c - 4)]; s += sh2[k] * w; } s = wave_sum(s); s += c < 4 ? a.in[IN_BRG][c] : a.in[IN_BRE][c - 4]; }
            if (F.lane == 0) bias2[c] = s; }
    }
}

typedef short bf16x8 __attribute__((ext_vector_type(8)));
__device__ __forceinline__ f32x4 mma16(bf16x8 a, bf16x8 b, f32x4 c) { return __builtin_amdgcn_mfma_f32_16x16x32_bf16(a, b, c, 0, 0, 0); }

template <int MODE>
__device__ __forceinline__ void conv4_pair(const Frame& F, const Args& a, int c, int pp) {
    const int t0 = c * 64;
    const bf16* U = (const bf16*)(F.ws + WS_U);
    const float* cw = a.in[IN_SCONVW]; const float* cb = a.in[IN_SCONVB];
    float wa[4], wb[4];
#pragma unroll
    for (int j = 0; j < 4; ++j) { wa[j] = cw[j * 1536 + 2 * pp]; wb[j] = cw[j * 1536 + 2 * pp + 1]; }
    const float bia = cb[2 * pp], bib = cb[2 * pp + 1];
    float p3a = 0.f, p3b = 0.f, p2a = 0.f, p2b = 0.f, p1a = 0.f, p1b = 0.f;
    if (c > 0) {
        const unsigned u3 = ((const unsigned*)(U + (size_t)(t0 - 3) * NU + 4096))[pp], u2 = ((const unsigned*)(U + (size_t)(t0 - 2) * NU + 4096))[pp], u1 = ((const unsigned*)(U + (size_t)(t0 - 1) * NU + 4096))[pp];
        p3a = bflo(u3); p3b = bfhi(u3); p2a = bflo(u2); p2b = bfhi(u2); p1a = bflo(u1); p1b = bfhi(u1);
    }
    bf16* xsT = (bf16*)(F.ws + WS_XS); bf16* Bm = (bf16*)(F.ws + WS_BM); bf16* Cm = (bf16*)(F.ws + WS_CM); bf16* BmT = (bf16*)(F.ws + WS_BMT);
    unsigned un[8];
#pragma unroll
    for (int i = 0; i < 8; ++i) un[i] = ((const unsigned*)(U + (size_t)(t0 + i) * NU + 4096))[pp];
#pragma unroll
    for (int tb = 0; tb < 8; ++tb) {
        unsigned uu[8];
#pragma unroll
        for (int i = 0; i < 8; ++i) uu[i] = un[i];
        if (tb < 7) {
#pragma unroll
            for (int i = 0; i < 8; ++i) un[i] = ((const unsigned*)(U + (size_t)(t0 + (tb + 1) * 8 + i) * NU + 4096))[pp]; }
        float ya[8], yb[8];
#pragma unroll
        for (int i = 0; i < 8; ++i) { const float ua = bflo(uu[i]), ub = bfhi(uu[i]);
            ya[i] = silu_f(wa[0] * p3a + wa[1] * p2a + wa[2] * p1a + wa[3] * ua + bia); yb[i] = silu_f(wb[0] * p3b + wb[1] * p2b + wb[2] * p1b + wb[3] * ub + bib);
            p3a = p2a; p3b = p2b; p2a = p1a; p2b = p1b; p1a = ua; p1b = ub; }
        if (MODE != 2) { v4u va, vb;
#pragma unroll
            for (int q = 0; q < 4; ++q) { va[q] = pk2(ya[2 * q], ya[2 * q + 1]); vb[q] = pk2(yb[2 * q], yb[2 * q + 1]); }
            if (MODE == 0) { bf16* o = xsT + ((size_t)c * 1024 + 2 * pp) * 64 + tb * 8; *(v4u*)o = va; *(v4u*)(o + 64) = vb; }
            else { bf16* o = BmT + ((size_t)c * 256 + 2 * (pp - 512)) * 64 + tb * 8; *(v4u*)o = va; *(v4u*)(o + 64) = vb; } }
        if (MODE == 1) {
#pragma unroll
            for (int i = 0; i < 8; ++i) ((unsigned*)(Bm + (size_t)(t0 + tb * 8 + i) * 256))[pp - 512] = pk2(ya[i], yb[i]); }
        if (MODE == 2) {
#pragma unroll
            for (int i = 0; i < 8; ++i) ((unsigned*)(Cm + (size_t)(t0 + tb * 8 + i) * 256))[pp - 640] = pk2(ya[i], yb[i]); }
    }
}

__device__ __forceinline__ void p3_chunk(const Frame& F, const Args& a, int c) {
    const int t0 = c * 64, tid = F.tid;
    const bf16* U = (const bf16*)(F.ws + WS_U); bf16* ymix = (bf16*)(F.ws + WS_YMIX);
    {
        const float* cw = a.in[IN_CONVW];
        const float w0a = cw[2 * tid], w0b = cw[2 * tid + 1], w1a = cw[1024 + 2 * tid], w1b = cw[1024 + 2 * tid + 1], w2a = cw[2048 + 2 * tid], w2b = cw[2048 + 2 * tid + 1];
        float p2a = 0.f, p2b = 0.f, p1a = 0.f, p1b = 0.f;
        if (c > 0) { const unsigned* u2 = (const unsigned*)(U + (size_t)(t0 - 2) * NU); const unsigned* u1 = (const unsigned*)(U + (size_t)(t0 - 1) * NU);
            const unsigned c2 = u2[512 + tid], v2 = u2[1024 + tid], c1 = u1[512 + tid], v1 = u1[1024 + tid];
            p2a = bflo(c2) * bflo(v2); p2b = bfhi(c2) * bfhi(v2); p1a = bflo(c1) * bflo(v1); p1b = bfhi(c1) * bfhi(v1); }
        unsigned nb_[8], nc_[8], nv_[8];
#pragma unroll
        for (int i = 0; i < 8; ++i) { const unsigned* ur = (const unsigned*)(U + (size_t)(t0 + i) * NU); nb_[i] = ur[tid]; nc_[i] = ur[512 + tid]; nv_[i] = ur[1024 + tid]; }
#pragma unroll
        for (int tb = 0; tb < 8; ++tb) {
            unsigned cb_[8], cc_[8], cv_[8];
#pragma unroll
            for (int i = 0; i < 8; ++i) { cb_[i] = nb_[i]; cc_[i] = nc_[i]; cv_[i] = nv_[i]; }
            if (tb < 7) {
#pragma unroll
                for (int i = 0; i < 8; ++i) { const unsigned* ur = (const unsigned*)(U + (size_t)(t0 + (tb + 1) * 8 + i) * NU); nb_[i] = ur[tid]; nc_[i] = ur[512 + tid]; nv_[i] = ur[1024 + tid]; } }
#pragma unroll
            for (int i = 0; i < 8; ++i) {
                const float cva = bflo(cc_[i]) * bflo(cv_[i]), cvb = bfhi(cc_[i]) * bfhi(cv_[i]);
                const float ya = bflo(cb_[i]) * (w0a * p2a + w1a * p1a + w2a * cva), yb = bfhi(cb_[i]) * (w0b * p2b + w1b * p1b + w2b * cvb);
                ((unsigned*)(ymix + (size_t)(t0 + tb * 8 + i) * D))[tid] = pk2(ya, yb);
                p2a = p1a; p2b = p1b; p1a = cva; p1b = cvb;
            }
        }
    }
    conv4_pair<0>(F, a, c, tid);
    if (tid < 128) conv4_pair<1>(F, a, c, tid + 512); else if (tid < 256) conv4_pair<2>(F, a, c, tid + 512);
    float* dtT = (float*)(F.ws + WS_DT); float* acsT = (float*)(F.ws + WS_ACS); const float* udt = (const float*)(F.ws + WS_UDT);
#pragma unroll
    for (int hi = 0; hi < 2; ++hi) {
        const int h = F.wave + 8 * hi; const float bias = a.in[IN_DTB][h], A = -expf(a.in[IN_ALOG][h]);
        const float x = udt[(size_t)(t0 + F.lane) * 16 + h] + bias; const float dt = fmaxf(x, 0.f) + log1pf(expf(-fabsf(x)));
        float cs = A * dt;
#pragma unroll
        for (int o = 1; o < 64; o <<= 1) { const float v = __shfl_up(cs, o); cs += (F.lane >= o) ? v : 0.f; }
        dtT[((size_t)c * 16 + h) * 64 + F.lane] = dt; acsT[((size_t)c * 16 + h) * 64 + F.lane] = cs;
    }
    asm volatile("s_waitcnt vmcnt(0)" ::: "memory");
    __syncthreads();
    const bf16* xsT = (const bf16*)(F.ws + WS_XS); const bf16* BmT = (const bf16*)(F.ws + WS_BMT); bf16* st = (bf16*)(F.ws + WS_ST);
    const int fr = F.lane & 15, fq = F.lane >> 4;
#pragma unroll 1
    for (int hi = 0; hi < 2; ++hi) {
        const int h = F.wave + 8 * hi, g = h >> 3;
        const float* dT = dtT + ((size_t)c * 16 + h) * 64; const float* aT = acsT + ((size_t)c * 16 + h) * 64; const float a63 = aT[63];
        bf16x8 xb[4][2];
#pragma unroll
        for (int ks = 0; ks < 2; ++ks) {
            const f32x4 d0 = *(const f32x4*)(dT + 32 * ks + 8 * fq), d1 = *(const f32x4*)(dT + 32 * ks + 8 * fq + 4), a0 = *(const f32x4*)(aT + 32 * ks + 8 * fq), a1 = *(const f32x4*)(aT + 32 * ks + 8 * fq + 4);
            float w[8];
#pragma unroll
            for (int j = 0; j < 4; ++j) { w[j] = d0[j] * __expf(a63 - a0[j]); w[4 + j] = d1[j] * __expf(a63 - a1[j]); }
#pragma unroll
            for (int nb = 0; nb < 4; ++nb) { const v4u raw = *(const v4u*)(xsT + ((size_t)c * 1024 + h * 64 + nb * 16 + fr) * 64 + 32 * ks + 8 * fq); v4u sc;
#pragma unroll
                for (int q = 0; q < 4; ++q) sc[q] = pk2(bflo(raw[q]) * w[2 * q], bfhi(raw[q]) * w[2 * q + 1]);
                xb[nb][ks] = __builtin_bit_cast(bf16x8, sc); }
        }
#pragma unroll 1
        for (int half = 0; half < 2; ++half) {
            f32x4 acc[4][4];
#pragma unroll
            for (int mb = 0; mb < 4; ++mb)
#pragma unroll
                for (int nb = 0; nb < 4; ++nb) acc[mb][nb] = (f32x4){0.f, 0.f, 0.f, 0.f};
#pragma unroll
            for (int ks = 0; ks < 2; ++ks)
#pragma unroll
                for (int mb = 0; mb < 4; ++mb) { const bf16x8 av = *(const bf16x8*)(BmT + ((size_t)c * 256 + g * 128 + half * 64 + mb * 16 + fr) * 64 + 32 * ks + 8 * fq);
#pragma unroll
                    for (int nb = 0; nb < 4; ++nb) acc[mb][nb] = mma16(av, xb[nb][ks], acc[mb][nb]); }
#pragma unroll
            for (int mb = 0; mb < 4; ++mb)
#pragma unroll
                for (int nb = 0; nb < 4; ++nb) { v2u w; w.x = pk2(acc[mb][nb][0], acc[mb][nb][1]); w.y = pk2(acc[mb][nb][2], acc[mb][nb][3]);
                    *(v2u*)(st + (((size_t)c * 16 + h) * 64 + nb * 16 + fr) * 128 + half * 64 + mb * 16 + 4 * fq) = w; }
        }
    }
}

__device__ __forceinline__ void p_scan(const Frame& F) {
    bf16* st = (bf16*)(F.ws + WS_ST); const float* acsT = (const float*)(F.ws + WS_ACS);
    for (int e = F.bid * NTHR + F.tid; e < 16 * 64 * 128; e += F.G * NTHR) {
        const int head = e >> 13; float h = 0.f;
#pragma unroll 1
        for (int cb = 0; cb < NCHUNK; cb += 32) {
            unsigned short sv[32]; float dv[32];
#pragma unroll
            for (int i = 0; i < 32; ++i) { sv[i] = st[(size_t)(cb + i) * 131072 + e]; dv[i] = acsT[((size_t)(cb + i) * 16 + head) * 64 + 63]; }
#pragma unroll
            for (int i = 0; i < 32; ++i) { st[(size_t)(cb + i) * 131072 + e] = (bf16)(pk2(h, 0.f) & 0xffffu); h = h * __expf(dv[i]) + bflo((unsigned)sv[i]); }
        }
    }
}

__device__ __forceinline__ void p4_unit(const Frame& F, const Args& a, int c, int g) {
    const int t0 = c * 64, hh = F.wave, h = g * 8 + hh, fr = F.lane & 15, fq = F.lane >> 4;
    const bf16* U = (const bf16*)(F.ws + WS_U); bf16* ymix = (bf16*)(F.ws + WS_YMIX);
    const bf16* xsT = (const bf16*)(F.ws + WS_XS); const bf16* Bm = (const bf16*)(F.ws + WS_BM); const bf16* Cm = (const bf16*)(F.ws + WS_CM);
    const float* dT = (const float*)(F.ws + WS_DT) + ((size_t)c * 16 + h) * 64; const float* aT = (const float*)(F.ws + WS_ACS) + ((size_t)c * 16 + h) * 64;
    const bf16* pv = (const bf16*)(F.ws + WS_ST) + ((size_t)c * 16 + h) * 64 * 128;
    LAS unsigned char* mbuf = F.lds + hh * 9216;
    LAS float* sred = (LAS float*)(F.lds + 73728);
    LAS float* srs = (LAS float*)(F.lds + 75776);
    float al[4];
#pragma unroll
    for (int nb = 0; nb < 4; ++nb) al[nb] = aT[nb * 16 + fr];
    bf16x8 cf[4][4];
#pragma unroll
    for (int nb = 0; nb < 4; ++nb)
#pragma unroll
        for (int ks = 0; ks < 4; ++ks) cf[nb][ks] = *(const bf16x8*)(Cm + (size_t)(t0 + nb * 16 + fr) * 256 + g * 128 + 32 * ks + 8 * fq);
    f32x4 acc[4][4];
#pragma unroll
    for (int mb = 0; mb < 4; ++mb)
#pragma unroll
        for (int nb = 0; nb < 4; ++nb) acc[mb][nb] = (f32x4){0.f, 0.f, 0.f, 0.f};
#pragma unroll
    for (int ks = 0; ks < 4; ++ks)
#pragma unroll
        for (int mb = 0; mb < 4; ++mb) { const bf16x8 bv = *(const bf16x8*)(Bm + (size_t)(t0 + mb * 16 + fr) * 256 + g * 128 + 32 * ks + 8 * fq);
#pragma unroll
            for (int nb = 0; nb < 4; ++nb) acc[mb][nb] = mma16(bv, cf[nb][ks], acc[mb][nb]); }
    {
        const float dsk = a.in[IN_DSKIP][h];
#pragma unroll
        for (int mb = 0; mb < 4; ++mb) { const f32x4 as = *(const f32x4*)(aT + mb * 16 + 4 * fq), ds = *(const f32x4*)(dT + mb * 16 + 4 * fq);
#pragma unroll
            for (int nb = 0; nb < 4; ++nb) { const int l = nb * 16 + fr; float m[4];
#pragma unroll
                for (int r = 0; r < 4; ++r) { const int s = mb * 16 + 4 * fq + r; const float v = acc[mb][nb][r] * __expf(al[nb] - as[r]) * ds[r]; m[r] = (s <= l) ? v : 0.f; m[r] += (s == l) ? dsk : 0.f; }
                v2u w; w.x = pk2(m[0], m[1]); w.y = pk2(m[2], m[3]);
                *(LAS v2u*)(mbuf + l * 144 + (mb * 16 + 4 * fq) * 2) = w; } }
    }
#pragma unroll
    for (int mb = 0; mb < 4; ++mb)
#pragma unroll
        for (int nb = 0; nb < 4; ++nb) acc[mb][nb] = (f32x4){0.f, 0.f, 0.f, 0.f};
#pragma unroll
    for (int ks = 0; ks < 4; ++ks)
#pragma unroll
        for (int mb = 0; mb < 4; ++mb) { const bf16x8 pvv = *(const bf16x8*)(pv + (size_t)(mb * 16 + fr) * 128 + 32 * ks + 8 * fq);
#pragma unroll
            for (int nb = 0; nb < 4; ++nb) acc[mb][nb] = mma16(pvv, cf[nb][ks], acc[mb][nb]); }
#pragma unroll
    for (int nb = 0; nb < 4; ++nb) { const float ea = __expf(al[nb]);
#pragma unroll
        for (int mb = 0; mb < 4; ++mb) acc[mb][nb] = acc[mb][nb] * ea; }
    LDS_WAIT();
#pragma unroll
    for (int ks = 0; ks < 2; ++ks) {
        bf16x8 mf[4];
#pragma unroll
        for (int nb = 0; nb < 4; ++nb) mf[nb] = *(const LAS bf16x8*)(mbuf + (nb * 16 + fr) * 144 + (32 * ks + 8 * fq) * 2);
#pragma unroll
        for (int mb = 0; mb < 4; ++mb) { const bf16x8 xv = *(const bf16x8*)(xsT + ((size_t)c * 1024 + h * 64 + mb * 16 + fr) * 64 + 32 * ks + 8 * fq);
#pragma unroll
            for (int nb = 0; nb < 4; ++nb) acc[mb][nb] = mma16(xv, mf[nb], acc[mb][nb]); }
    }
    float ss[4] = {0.f, 0.f, 0.f, 0.f};
#pragma unroll
    for (int nb = 0; nb < 4; ++nb)
#pragma unroll
        for (int mb = 0; mb < 4; ++mb) { const v2u zv = *(const v2u*)(U + (size_t)(t0 + nb * 16 + fr) * NU + 3072 + h * 64 + mb * 16 + 4 * fq);
            f32x4 y = acc[mb][nb]; y[0] *= silu_f(bflo(zv.x)); y[1] *= silu_f(bfhi(zv.x)); y[2] *= silu_f(bflo(zv.y)); y[3] *= silu_f(bfhi(zv.y));
            acc[mb][nb] = y; ss[nb] += (y[0] * y[0] + y[1] * y[1]) + (y[2] * y[2] + y[3] * y[3]); }
#pragma unroll
    for (int nb = 0; nb < 4; ++nb) { float s = ss[nb]; s += __shfl_xor(s, 16); s += __shfl_xor(s, 32); if (fq == 0) sred[hh * 64 + nb * 16 + fr] = s; }
    __syncthreads();
    if (F.tid < 64) { float s = 0.f;
#pragma unroll
        for (int w = 0; w < 8; ++w) s += sred[w * 64 + F.tid];
        srs[F.tid] = 1.f / sqrtf(s * (1.f / 512.f) + EPS); }
    __syncthreads();
    {
        const float* nw = a.in[IN_SNW] + h * 64;
#pragma unroll
        for (int nb = 0; nb < 4; ++nb) { const float r = srs[nb * 16 + fr];
#pragma unroll
            for (int mb = 0; mb < 4; ++mb) { const f32x4 n4 = *(const f32x4*)(nw + mb * 16 + 4 * fq); const f32x4 y = acc[mb][nb] * r * n4;
                v2u w; w.x = pk2(y[0], y[1]); w.y = pk2(y[2], y[3]);
                *(v2u*)(ymix + (size_t)(t0 + nb * 16 + fr) * D + 1024 + h * 64 + mb * 16 + 4 * fq) = w; } }
    }
    __syncthreads();
}

__device__ __forceinline__ void p6_unit(const Frame& F, const Args& a, int u) {
    const int t0 = u * 64, tid = F.tid, lane = F.lane, wave = F.wave;
    const float* X1 = a.out; const float* w2t = (const float*)(F.ws + WS_W2T); const float* bias2 = (const float*)(F.ws + WS_BIAS2);
    const float* mod = (const float*)(F.ws + WS_MOD);
    LAS float* spart = (LAS float*)F.lds;
    LAS float* sssq = (LAS float*)(F.lds + 98304);
    LAS float* srstd = (LAS float*)(F.lds + 100352);
    LAS int* seid = (LAS int*)(F.lds + 100608);
    LAS int* shist = (LAS int*)(F.lds + 101120);
    const int r16 = lane & 15, q = lane >> 4, k0 = wave * 256 + 4 * q;
    f32x4 acc[4][3];
#pragma unroll
    for (int rb = 0; rb < 4; ++rb)
#pragma unroll
        for (int cb = 0; cb < 3; ++cb) acc[rb][cb] = (f32x4){0.f, 0.f, 0.f, 0.f};
    float ssq[4] = {0.f, 0.f, 0.f, 0.f};
    const float* xrow = X1 + (size_t)(t0 + r16) * D + k0;
    const float* wrow = w2t + (size_t)r16 * D + k0;
#pragma unroll 2
    for (int s = 0; s < 16; ++s) {
        f32x4 av[4], bv[3];
#pragma unroll
        for (int rb = 0; rb < 4; ++rb) av[rb] = *(const f32x4*)(xrow + (size_t)rb * 16 * D + 16 * s);
#pragma unroll
        for (int cb = 0; cb < 3; ++cb) bv[cb] = *(const f32x4*)(wrow + (size_t)cb * 16 * D + 16 * s);
#pragma unroll
        for (int rb = 0; rb < 4; ++rb) ssq[rb] += (av[rb].x * av[rb].x + av[rb].y * av[rb].y) + (av[rb].z * av[rb].z + av[rb].w * av[rb].w);
#pragma unroll
        for (int e = 0; e < 4; ++e)
#pragma unroll
            for (int rb = 0; rb < 4; ++rb)
#pragma unroll
                for (int cb = 0; cb < 3; ++cb) acc[rb][cb] = __builtin_amdgcn_mfma_f32_16x16x4f32(av[rb][e], bv[cb][e], acc[rb][cb], 0, 0, 0);
    }
#pragma unroll
    for (int rb = 0; rb < 4; ++rb)
#pragma unroll
        for (int cb = 0; cb < 3; ++cb)
#pragma unroll
            for (int r = 0; r < 4; ++r) spart[(wave * 64 + rb * 16 + 4 * q + r) * 48 + cb * 16 + r16] = acc[rb][cb][r];
#pragma unroll
    for (int rb = 0; rb < 4; ++rb) { float s = ssq[rb]; s += __shfl_xor(s, 16); s += __shfl_xor(s, 32); if (q == 0) sssq[wave * 64 + rb * 16 + r16] = s; }
    if (tid < 32) shist[tid] = 0;
    __syncthreads();
    LAS float* slog = (LAS float*)(F.lds + 102400);
    for (int i = tid; i < 64 * 48; i += NTHR) { float v = 0.f;
#pragma unroll
        for (int w = 0; w < 8; ++w) v += spart[w * 64 * 48 + i];
        slog[i] = v; }
    if (tid < 64) { float s = 0.f;
#pragma unroll
        for (int w = 0; w < 8; ++w) s += sssq[w * 64 + tid];
        srstd[tid] = 1.f / sqrtf(s * (1.f / D) + EPS); }
    __syncthreads();
    if (tid < 64) {
        const float rstd = srstd[tid];
        float lg[36];
#pragma unroll
        for (int c = 0; c < 36; ++c) lg[c] = slog[tid * 48 + c] * rstd + bias2[c];
        int gi = 0; float gm = lg[0];
#pragma unroll
        for (int c = 1; c < 4; ++c) if (lg[c] > gm) { gm = lg[c]; gi = c; }
        float gs = 0.f;
#pragma unroll
        for (int c = 0; c < 4; ++c) gs += expf(lg[c] - gm);
        const float grp_p = 1.f / gs;
        float le[8];
#pragma unroll
        for (int j = 0; j < 8; ++j) { float v = lg[4 + j];
#pragma unroll
            for (int g2 = 1; g2 < 4; ++g2) v = (gi == g2) ? lg[4 + g2 * 8 + j] : v;
            le[j] = v; }
        int j1 = 0; float m1 = le[0];
#pragma unroll
        for (int j = 1; j < 8; ++j) if (le[j] > m1) { m1 = le[j]; j1 = j; }
        int j2 = -1; float m2 = -3.0e38f;
#pragma unroll
        for (int j = 0; j < 8; ++j) if (j != j1 && le[j] > m2) { m2 = le[j]; j2 = j; }
        const float e2 = expf(m2 - m1), w1 = grp_p / (1.f + e2), w2 = grp_p * e2 / (1.f + e2);
        const int ex1 = gi * 8 + j1, ex2 = gi * 8 + j2, t = t0 + tid;
        ((int*)(F.ws + WS_EID))[2 * t] = ex1; ((int*)(F.ws + WS_EID))[2 * t + 1] = ex2;
        ((float*)(F.ws + WS_EW))[2 * t] = w1; ((float*)(F.ws + WS_EW))[2 * t + 1] = w2;
        seid[2 * tid] = ex1; seid[2 * tid + 1] = ex2;
        __hip_atomic_fetch_add(&shist[ex1], 1, __ATOMIC_RELAXED, __HIP_MEMORY_SCOPE_WORKGROUP); __hip_atomic_fetch_add(&shist[ex2], 1, __ATOMIC_RELAXED, __HIP_MEMORY_SCOPE_WORKGROUP);
    }
    __syncthreads();
    if (tid < 32) ((int*)(F.ws + WS_BLKCNT))[u * 32 + tid] = shist[tid];
    if (tid < 128) { const int e = seid[tid]; int r = 0; for (int j = 0; j < tid; ++j) r += (seid[j] == e) ? 1 : 0; ((int*)(F.ws + WS_RANK))[2 * t0 + tid] = r; }
    {
        const float* n2w = a.in[IN_N2W]; const float* sh2 = mod + 3 * D; const float* sc2 = mod + 4 * D; bf16* H = (bf16*)(F.ws + WS_H);
        f32x4 av2[8], bv2[8];
#pragma unroll
        for (int j = 0; j < 8; ++j) { const int k = 4 * lane + 256 * j; const f32x4 w = *(const f32x4*)(n2w + k), s = *(const f32x4*)(sc2 + k); av2[j] = w * (s + 1.f); bv2[j] = *(const f32x4*)(sh2 + k); }
#pragma unroll 1
        for (int i = 0; i < 8; i += 2) {
            f32x4 xv[2][8];
#pragma unroll
            for (int u2 = 0; u2 < 2; ++u2)
#pragma unroll
                for (int j = 0; j < 8; ++j) xv[u2][j] = ((const f32x4*)(X1 + (size_t)(t0 + wave * 8 + i + u2) * D) + lane)[64 * j];
#pragma unroll
            for (int u2 = 0; u2 < 2; ++u2) { const int tok = wave * 8 + i + u2; const float rstd = srstd[tok]; v2u* o = (v2u*)(H + (size_t)(t0 + tok) * D) + lane;
#pragma unroll
                for (int j = 0; j < 8; ++j) { const f32x4 hv = xv[u2][j] * rstd * av2[j] + bv2[j]; v2u pw; pw.x = pk2(hv.x, hv.y); pw.y = pk2(hv.z, hv.w); o[64 * j] = pw; } }
        }
    }
    __syncthreads();
}

__device__ __forceinline__ void p7_unit(const Frame& F, int u) {
    const int t0 = u * 64, tid = F.tid;
    const int* blkcnt = (const int*)(F.ws + WS_BLKCNT); int* slot = (int*)(F.ws + WS_SLOT); const int* eid = (const int*)(F.ws + WS_EID);
    LAS int* stot = (LAS int*)F.lds;
    LAS int* sbef = (LAS int*)(F.lds + 128);
    LAS int* sbase = (LAS int*)(F.lds + 256);
    LAS int* sslot = (LAS int*)(F.lds + 512);
    LAS int* scnt = (LAS int*)(F.lds + 1024);
    for (int i = tid; i < NCHUNK * 32 / 4; i += NTHR) *(LAS v4u*)(scnt + 4 * i) = *(const v4u*)(blkcnt + 4 * i);
    __syncthreads();
    if (tid < 32) { int tot = 0, bef = 0;
#pragma unroll 8
        for (int b = 0; b < NCHUNK; ++b) { const int v = scnt[b * 32 + tid]; tot += v; bef += (b < u) ? v : 0; } stot[tid] = tot; sbef[tid] = bef; }
    __syncthreads();
    if (tid == 0) { int ps = 0; for (int e = 0; e < 32; ++e) { sbase[e] = ps + sbef[e];
            if (u == 0) { int* tile_e = (int*)(F.ws + WS_TILE); for (int i = ps >> 8; i < ((ps + ((stot[e] + 255) & ~255)) >> 8); ++i) tile_e[i] = e; }
            ps += (stot[e] + 255) & ~255; }
        if (u == 0) ((int*)(F.ws + WS_TILE))[192] = ps >> 8; }
    __syncthreads();
    if (tid < 128) { const int s = sbase[eid[2 * t0 + tid]] + ((const int*)(F.ws + WS_RANK))[2 * t0 + tid]; sslot[tid] = s; slot[2 * t0 + tid] = s; }
    __syncthreads();
    const bf16* H = (const bf16*)(F.ws + WS_H); bf16* hs = (bf16*)(F.ws + WS_U);
    for (int i = 0; i < 16; ++i) { const int a = F.wave * 16 + i, s = sslot[a]; const v4u* src = (const v4u*)(H + (size_t)(t0 + (a >> 1)) * D) + F.lane; v4u* dst = (v4u*)(hs + (size_t)s * D) + F.lane;
#pragma unroll
        for (int j = 0; j < 4; ++j) dst[64 * j] = src[64 * j]; }
    __syncthreads();
}

__device__ __forceinline__ void p10_rows(const Frame& F, const Args& a) {
    const float* mod = (const float*)(F.ws + WS_MOD); const float* g2 = mod + 5 * D; const float* fw = a.in[IN_FNW];
    const int* slot = (const int*)(F.ws + WS_SLOT); const float* ew = (const float*)(F.ws + WS_EW); const bf16* yb = (const bf16*)(F.ws + WS_YB);
    float dbg = 0.f;
#if defined(MK_DEBUG_CHECK)
    dbg = __builtin_bit_cast(float, __hip_atomic_load((unsigned*)(F.ws + WS_CTL) + CW_DBG, __ATOMIC_RELAXED, __HIP_MEMORY_SCOPE_AGENT));
#endif
    const int gw = F.bid * NWAVES + F.wave, NGW = F.G * NWAVES;
    f32x4 gv[8], fv[8];
#pragma unroll
    for (int j = 0; j < 8; ++j) { const int k = 4 * F.lane + 256 * j; gv[j] = *(const f32x4*)(g2 + k); fv[j] = *(const f32x4*)(fw + k); }
    f32x4 nx[8]; v2u ny0[8], ny1[8]; float nw0 = 0.f, nw1 = 0.f;
#define P10_LOAD(row_) do { const int s0_ = slot[2 * (row_)], s1_ = slot[2 * (row_) + 1]; nw0 = ew[2 * (row_)]; nw1 = ew[2 * (row_) + 1]; \
        const float* xr_ = a.out + (size_t)(row_) * D; const v2u* y0_ = (const v2u*)(yb + (size_t)s0_ * D) + F.lane; const v2u* y1_ = (const v2u*)(yb + (size_t)s1_ * D) + F.lane; \
        _Pragma("unroll") for (int j = 0; j < 8; ++j) { nx[j] = *(const f32x4*)(xr_ + 4 * F.lane + 256 * j); ny0[j] = y0_[64 * j]; ny1[j] = y1_[64 * j]; } } while (0)
    if (gw < T) P10_LOAD(gw);
    for (int row = gw; row < T; row += NGW) {
        f32x4 v[8]; float s = 0.f; const float w0 = nw0, w1 = nw1;
#pragma unroll
        for (int j = 0; j < 8; ++j) { const v2u a0 = ny0[j], a1 = ny1[j];
            f32x4 m; m.x = w0 * bflo(a0.x) + w1 * bflo(a1.x); m.y = w0 * bfhi(a0.x) + w1 * bfhi(a1.x); m.z = w0 * bflo(a0.y) + w1 * bflo(a1.y); m.w = w0 * bfhi(a0.y) + w1 * bfhi(a1.y);
            v[j] = nx[j] + gv[j] * m; s += (v[j].x * v[j].x + v[j].y * v[j].y) + (v[j].z * v[j].z + v[j].w * v[j].w); }
        if (row + NGW < T) P10_LOAD(row + NGW);
        const float rstd = (1.f + dbg) / sqrtf(wave_sum(s) * (1.f / D) + EPS);
        float* xr = a.out + (size_t)row * D;
#pragma unroll
        for (int j = 0; j < 8; ++j) *(f32x4*)(xr + 4 * F.lane + 256 * j) = v[j] * rstd * fv[j];
    }
#undef P10_LOAD
}

constexpr int NPHASES = 12;
__global__ void __launch_bounds__(NTHR, 2) mk_fwd(Args args) {
    extern __shared__ __attribute__((aligned(16))) unsigned char lds_raw[];
    Frame F;
    F.lds = (LAS unsigned char*)lds_raw;
    F.tid = threadIdx.x; F.lane = F.tid & 63; F.wave = __builtin_amdgcn_readfirstlane(F.tid >> 6);
    F.G = gridDim.x; F.bid = blockIdx.x; F.vcu = (F.G % 8 == 0) ? (F.bid % 8) * (F.G / 8) + F.bid / 8 : F.bid;
    F.ws = args.ws;
    volatile LAS unsigned* MISC = (volatile LAS unsigned*)(F.lds + MISC_OFF);
    if (F.tid < 16) MISC[F.tid] = 0u;
    __syncthreads();
    const int lo = args.ph_lo, hi = args.ph_hi;
    XcdBarrier bar; bar.bar = (unsigned*)(F.ws + WS_CTL) + CW_BAR + args.li * XCD_BAR_WORDS; bar.x = 0; bar.st = nullptr;
    if (hi - lo > 1) bar = xcd_barrier_post((unsigned*)(F.ws + WS_CTL) + CW_BAR + args.li * XCD_BAR_WORDS, MISC + 8);
#define IN(k) (lo <= (k) && (k) < hi)
#define SEAM(k) do { if (IN(k) && IN((k) + 1)) xcd_barrier(bar); } while (0)
    float* mod = (float*)(F.ws + WS_MOD);

    if (IN(0)) { p0_ada(F, args.in[IN_C], args.in[IN_WADA], args.in[IN_BADA], mod); p0_convert(F, args); }
    SEAM(0);
    if (IN(1)) { norm_rows(F, args.in[IN_X], args.in[IN_N1W], mod + D, mod, (bf16*)(F.ws + WS_H)); p1_router_prep(F, args); }
    SEAM(1);
    if (IN(2)) {
        pg8::Gemm g{(const pg8::bf16_t*)(F.ws + WS_H), (const pg8::bf16_t*)(F.ws + WS_WIN), T, N_IN_PAD, D, 0}; ConvOrder S; S.init(T, N_IN_PAD, F.G, F.bid);
        S.J = ConvJob{args.in[IN_WG], args.in[IN_WU], args.in[IN_WD], (bf16*)(F.ws + WS_WGU), (bf16*)(F.ws + WS_WD)};
        const int nmy = (S.nwg - F.bid + F.G - 1) / F.G, gwv = F.bid * NWAVES + F.wave, per = 65536 / (F.G * NWAVES);
        S.pos = nmy > 0 ? (((F.bid >> 3) % 5) < nmy ? ((F.bid >> 3) % 5) : nmy - 1) : -1; S.it0 = gwv * per; S.nit = per;
        pg8::EpiU E{(pg8::bf16_t*)(F.ws + WS_U), (float*)(F.ws + WS_UDT)};
        pg8::gemm_phase<pg8::EpiU, ConvOrder, true, true>(F.lds, g, S, E);
    }
    SEAM(2);
    if (IN(3)) { for (int c = F.bid; c < NCHUNK; c += F.G) p3_chunk(F, args, c); }
    SEAM(3);
    if (IN(4)) p_scan(F);
    SEAM(4);
    if (IN(5)) { for (int u = F.bid; u < 2 * NCHUNK; u += F.G) p4_unit(F, args, u >> 1, u & 1); }
    SEAM(5);
    if (IN(6)) {
        pg8::Gemm g{(const pg8::bf16_t*)(F.ws + WS_YMIX), (const pg8::bf16_t*)(F.ws + WS_WOUT), T, D, D, 0}; ConvOrder S; S.init(T, D, F.G, F.bid);
        S.J = ConvJob{args.in[IN_WG], args.in[IN_WU], args.in[IN_WD], (bf16*)(F.ws + WS_WGU), (bf16*)(F.ws + WS_WD)};
        const int nmy = (S.nwg - F.bid + F.G - 1) / F.G, gwv = F.bid * NWAVES + F.wave, per = 32768 / (F.G * NWAVES);
        S.pos = nmy > 0 ? (((F.bid >> 3) & 1) < nmy ? ((F.bid >> 3) & 1) : nmy - 1) : -1; S.it0 = 65536 + gwv * per; S.nit = per;
        pg8::EpiX1 E{args.in[IN_X], args.out, mod + 2 * D};
        pg8::gemm_phase<pg8::EpiX1, ConvOrder, true, true>(F.lds, g, S, E);
    }
    SEAM(6);
    if (IN(7)) { for (int u = F.bid; u < NCHUNK; u += F.G) p6_unit(F, args, u); }
    SEAM(7);
    if (IN(8)) { for (int u = F.bid; u < NCHUNK; u += F.G) p7_unit(F, u); }
    SEAM(8);
    if (IN(9)) {
        const int ntiles = __builtin_amdgcn_readfirstlane(__hip_atomic_load((int*)(F.ws + WS_TILE) + 192, __ATOMIC_RELAXED, __HIP_MEMORY_SCOPE_AGENT));
        pg8::Gemm g{(const pg8::bf16_t*)(F.ws + WS_U), (const pg8::bf16_t*)(F.ws + WS_WGU), ntiles * 256, 2048, D, (size_t)2048 * D * 2};
        pg8::MoeOrder S{(const int*)(F.ws + WS_TILE), ntiles * 8, 8, F.G, F.vcu};
        pg8::EpiHid E{(pg8::bf16_t*)(F.ws + WS_YMIX)};
        pg8::gemm_phase<pg8::EpiHid, pg8::MoeOrder, true, true, true>(F.lds, g, S, E);
    }
    SEAM(9);
    if (IN(10)) {
        const int ntiles = __builtin_amdgcn_readfirstlane(__hip_atomic_load((int*)(F.ws + WS_TILE) + 192, __ATOMIC_RELAXED, __HIP_MEMORY_SCOPE_AGENT));
        pg8::Gemm g{(const pg8::bf16_t*)(F.ws + WS_YMIX), (const pg8::bf16_t*)(F.ws + WS_WD), ntiles * 256, 2048, FF, (size_t)2048 * FF * 2};
        pg8::MoeOrder S{(const int*)(F.ws + WS_TILE), ntiles * 8, 8, F.G, F.vcu};
        pg8::EpiY E{(pg8::bf16_t*)(F.ws + WS_YB)};
        pg8::gemm_phase<pg8::EpiY, pg8::MoeOrder, true, true, true>(F.lds, g, S, E);
    }
    SEAM(10);
    if (IN(11)) p10_rows(F, args);
#undef IN
#undef SEAM
}

extern "C" void kernel_launch(void* const* d_in, const int* in_sizes, int n_in, void* d_out, int out_size, void* d_ws, size_t ws_size, hipStream_t stream) {
    static int grid = 0;
    if (grid == 0) {
        if (n_in != N_INPUTS || in_sizes[0] != T * D || out_size != T * D || ws_size < WS_END) { fprintf(stderr, "kernel_launch: unexpected shapes (n_in %d, in0 %d, out %d, ws %zu < %zu); nothing launched\n", n_in, n_in > 0 ? in_sizes[0] : -1, out_size, ws_size, (size_t)WS_END); grid = -1; return; }
        int dev = 0, cus = 0, per_cu = 0;
        if (hipGetDevice(&dev) != hipSuccess || hipDeviceGetAttribute(&cus, hipDeviceAttributeMultiprocessorCount, dev) != hipSuccess) { fprintf(stderr, "kernel_launch: device query failed\n"); grid = -1; return; }
        if (hipFuncSetAttribute((const void*)mk_fwd, hipFuncAttributeMaxDynamicSharedMemorySize, LDS_BYTES) != hipSuccess) { fprintf(stderr, "kernel_launch: hipFuncSetAttribute failed\n"); grid = -1; return; }
        if (hipOccupancyMaxActiveBlocksPerMultiprocessor(&per_cu, (const void*)mk_fwd, NTHR, LDS_BYTES) != hipSuccess || per_cu < 1) fprintf(stderr, "kernel_launch: note: occupancy query reports %d workgroups per CU\n", per_cu);
        (void)hipGetLastError();
        grid = cus;
    }
    if (grid < 0) return;
    if (hipMemsetAsync((char*)d_ws + WS_CTL, 0, CTL_ZERO_BYTES, stream) != hipSuccess) { fprintf(stderr, "kernel_launch: memset failed\n"); return; }
    Args a{};
    for (int i = 0; i < N_INPUTS; ++i) a.in[i] = (const float*)d_in[i];
    a.out = (float*)d_out; a.ws = (unsigned char*)d_ws;
#if defined(MK_PROBE) && MK_PROBE == 1
    static const int cuts[][2] = {{0, 1}, {0, 12}};
#elif defined(MK_PROBE) && MK_PROBE == 2
    static const int cuts[][2] = {{0, 3}, {1, 12}};
#elif defined(MK_PROBE) && MK_PROBE == 3
    static const int cuts[][2] = {{0, 6}, {3, 12}};
#elif defined(MK_PROBE) && MK_PROBE == 4
    static const int cuts[][2] = {{0, 8}, {6, 12}};
#elif defined(MK_PROBE) && MK_PROBE == 5
    static const int cuts[][2] = {{0, 11}, {9, 12}};
#elif defined(MK_PROBE) && MK_PROBE == 6
    static const int cuts[][2] = {{0, 4}, {3, 12}};
#elif defined(MK_PROBE) && MK_PROBE == 7
    static const int cuts[][2] = {{0, 6}, {5, 12}};
#elif defined(MK_PROBE) && MK_PROBE == 8
    static const int cuts[][2] = {{0, 8}, {7, 12}};
#elif defined(MK_PROBE) && MK_PROBE == 9
    static const int cuts[][2] = {{0, 7}, {6, 12}};
#elif defined(MK_PROBE) && MK_PROBE == 10
    static const int cuts[][2] = {{0, 9}, {8, 12}};
#elif defined(MK_PROBE) && MK_PROBE == 11
    static const int cuts[][2] = {{0, 5}, {12, 12}, {4, 12}};
#elif MK_N_LAUNCHES == 1
    static const int cuts[][2] = {{0, NPHASES}};
#else
    static const int cuts[][2] = {{0, 1}, {1, 2}, {2, 3}, {3, 4}, {4, 5}, {5, 6}, {6, 7}, {7, 8}, {8, 9}, {9, 10}, {10, 11}, {11, 12}};
#endif
    for (int li = 0; li < (int)(sizeof(cuts) / sizeof(cuts[0])); ++li) { a.ph_lo = cuts[li][0]; a.ph_hi = cuts[li][1]; a.li = li; hipLaunchKernelGGL(mk_fwd, dim3(grid), dim3(NTHR), LDS_BYTES, stream, a); }
    const hipError_t le = hipPeekAtLastError();
    if (le != hipSuccess) fprintf(stderr, "kernel_launch: launch failed: %s\n", hipGetErrorName(le));
}
```

```cpp
#include <hip/hip_runtime.h>
#include <cstdio>
#include <cstdint>

#ifndef MK_N_LAUNCHES
#define MK_N_LAUNCHES 1
#endif

namespace pg8 {
#define PG8_LAS __attribute__((address_space(3)))
typedef unsigned short bf16_t;
typedef short bf16x8 __attribute__((ext_vector_type(8)));
typedef float f32x4 __attribute__((ext_vector_type(4)));
typedef unsigned u32x4 __attribute__((ext_vector_type(4)));
constexpr int BM = 256, BK = 64, HALF = 128, HTB = HALF * BK * 2  , STAGE_BYTES = 8 * HTB, NXCD = 8, WGM = 8;

__host__ __device__ __forceinline__ int lds_byte(int r, int c) { const int st = (r >> 4) * 2 + (c >> 5), rr = r & 15, cc = c & 31, ob = rr * 64 + cc * 2; return st * 1024 + (ob ^ (((ob >> 9) & 1) << 5)); }
__host__ __device__ __forceinline__ void stage_rc(int b, int& R, int& C) { const int st = b / 1024, sb = b % 1024, swz = sb ^ (((sb >> 9) & 1) << 5); R = (st >> 1) * 16 + swz / 64; C = (st & 1) * 32 + (swz % 64) / 2; }
__host__ __device__ __forceinline__ int perm32(int rho) { const int n = rho >> 4, i = rho & 15; return 8 * (i >> 2) + 4 * n + (i & 3); }

struct Unit { int pm, pn, pb, pe; };
struct Gemm { const bf16_t* A; const bf16_t* Bt; int M, N, K; size_t estep; };

struct StaticOrder {
    int nM, nN, nwg, G, c;
    __host__ __device__ void init(int M, int N, int G_, int c_) { nM = M / BM; nN = N / BM; nwg = nM * nN; G = G_; c = c_; }
    __host__ __device__ bool next(int i, Unit& u) const {
        const long L = (long)i * G + c; if (L >= nwg) return false;
        int wgid = (int)L; { const int q = nwg / NXCD, r = nwg % NXCD, xcd = wgid % NXCD, off = wgid / NXCD; wgid = (xcd < r ? xcd * (q + 1) : r * (q + 1) + (xcd - r) * q) + off; }
        const int nig = WGM * nN, gid = wgid / nig, fm = gid * WGM, gsz = (nM - fm) < WGM ? (nM - fm) : WGM;
        u.pm = fm + ((wgid % nig) % gsz); u.pn = (wgid % nig) / gsz; u.pb = u.pn; u.pe = 0; return true;
    }
    __device__ __forceinline__ void a_ready(const Unit&) const {}
    __device__ __forceinline__ void done(const Unit&, int) const {}
};
struct MoeOrder {
    const int* tile_e; int nunits, ncol, G, c;
    __device__ bool next(int i, Unit& u) const {
        const long L = (long)i * G + c; if (L >= nunits) return false;
        u.pm = (int)L / ncol; u.pn = (int)L % ncol;
        const int e = __builtin_amdgcn_readfirstlane(__hip_atomic_load((int*)tile_e + u.pm, __ATOMIC_RELAXED, __HIP_MEMORY_SCOPE_AGENT));
        u.pb = u.pn; u.pe = e; return true;
    }
    __device__ __forceinline__ void a_ready(const Unit&) const {}
    __device__ __forceinline__ void done(const Unit&, int) const {}
};

typedef float f32x2_t __attribute__((ext_vector_type(2)));
typedef __bf16 bf16x2_t __attribute__((ext_vector_type(2)));
__device__ __forceinline__ unsigned cvt_pk_bf16(float lo, float hi) { const f32x2_t v = {lo, hi}; const bf16x2_t b = __builtin_convertvector(v, bf16x2_t); return __builtin_bit_cast(unsigned, b); }

struct EpiU {
    static constexpr bool PERM = true, AFTER_DRAIN = false;
    bf16_t* U; float* udt;
    __device__ __forceinline__ void operator()(const f32x4 (&acc)[2][2][4][2], const Unit& u, int wr, int wc, int fr, int fq) const {
        const int row0 = u.pm * BM + wr * 64 + fr;
        if (u.pn < 22) {
            const int col0 = u.pn * BM + wc * 32 + 8 * fq;
#pragma unroll
            for (int ai = 0; ai < 2; ++ai)
#pragma unroll
                for (int m = 0; m < 4; ++m) { bf16_t* rowp = U + (size_t)(row0 + ai * HALF + m * 16) * 5632 + col0;
#pragma unroll
                    for (int bj = 0; bj < 2; ++bj) { const f32x4 v0 = acc[ai][bj][m][0], v1 = acc[ai][bj][m][1];
                        u32x4 w; w.x = cvt_pk_bf16(v0[0], v0[1]); w.y = cvt_pk_bf16(v0[2], v0[3]); w.z = cvt_pk_bf16(v1[0], v1[1]); w.w = cvt_pk_bf16(v1[2], v1[3]);
                        *(u32x4*)(rowp + bj * HALF) = w; } }
        } else if (wc == 0 && fq < 2) {
#pragma unroll
            for (int ai = 0; ai < 2; ++ai)
#pragma unroll
                for (int m = 0; m < 4; ++m) { float* rowp = udt + (size_t)(row0 + ai * HALF + m * 16) * 16 + 8 * fq;
                    *(f32x4*)(rowp) = acc[ai][0][m][0]; *(f32x4*)(rowp + 4) = acc[ai][0][m][1]; }
        }
    }
};
struct EpiX1 {
    static constexpr bool PERM = false, AFTER_DRAIN = false;
    const float* X; float* O; const float* gate;
    __device__ __forceinline__ void operator()(const f32x4 (&acc)[2][2][4][2], const Unit& u, int wr, int wc, int fr, int fq) const {
        const int row0 = u.pm * BM + wr * 64 + fr, col0 = u.pn * BM + wc * 32 + 4 * fq;
        f32x4 gv[2][2];
#pragma unroll
        for (int bj = 0; bj < 2; ++bj)
#pragma unroll
            for (int n = 0; n < 2; ++n) gv[bj][n] = *(const f32x4*)(gate + col0 + bj * HALF + n * 16);
#pragma unroll
        for (int ai = 0; ai < 2; ++ai)
#pragma unroll
            for (int m = 0; m < 4; ++m) { const size_t ro = (size_t)(row0 + ai * HALF + m * 16) * 2048 + col0;
#pragma unroll
                for (int bj = 0; bj < 2; ++bj)
#pragma unroll
                    for (int n = 0; n < 2; ++n) { const f32x4 xv = *(const f32x4*)(X + ro + bj * HALF + n * 16);
                        *(f32x4*)(O + ro + bj * HALF + n * 16) = xv + gv[bj][n] * acc[ai][bj][m][n]; } }
    }
};
struct EpiHid {
    static constexpr bool PERM = true, AFTER_DRAIN = false;
    bf16_t* Hd;
    __device__ __forceinline__ void operator()(const f32x4 (&acc)[2][2][4][2], const Unit& u, int wr, int wc, int fr, int fq) const {
        const int row0 = u.pm * BM + wr * 64 + fr, col0 = u.pn * HALF + wc * 32 + 8 * fq;
#pragma unroll
        for (int ai = 0; ai < 2; ++ai)
#pragma unroll
            for (int m = 0; m < 4; ++m) { bf16_t* rowp = Hd + (size_t)(row0 + ai * HALF + m * 16) * 1024 + col0;
                float r[8];
#pragma unroll
                for (int n = 0; n < 2; ++n)
#pragma unroll
                    for (int j = 0; j < 4; ++j) { const float g = acc[ai][0][m][n][j], up = acc[ai][1][m][n][j]; r[4 * n + j] = g / (1.f + __expf(-g)) * up; }
                u32x4 w; w.x = cvt_pk_bf16(r[0], r[1]); w.y = cvt_pk_bf16(r[2], r[3]); w.z = cvt_pk_bf16(r[4], r[5]); w.w = cvt_pk_bf16(r[6], r[7]);
                *(u32x4*)(rowp) = w; }
    }
};
struct EpiY {
    static constexpr bool PERM = true, AFTER_DRAIN = false;
    bf16_t* Y;
    __device__ __forceinline__ void operator()(const f32x4 (&acc)[2][2][4][2], const Unit& u, int wr, int wc, int fr, int fq) const {
        const int row0 = u.pm * BM + wr * 64 + fr, col0 = u.pn * BM + wc * 32 + 8 * fq;
#pragma unroll
        for (int ai = 0; ai < 2; ++ai)
#pragma unroll
            for (int m = 0; m < 4; ++m) { bf16_t* rowp = Y + (size_t)(row0 + ai * HALF + m * 16) * 2048 + col0;
#pragma unroll
                for (int bj = 0; bj < 2; ++bj) { const f32x4 v0 = acc[ai][bj][m][0], v1 = acc[ai][bj][m][1];
                    u32x4 w; w.x = cvt_pk_bf16(v0[0], v0[1]); w.y = cvt_pk_bf16(v0[2], v0[3]); w.z = cvt_pk_bf16(v1[0], v1[1]); w.w = cvt_pk_bf16(v1[2], v1[3]);
                    *(u32x4*)(rowp + bj * HALF) = w; } }
    }
};

template <class Epi, class Sched, bool ALIGN_EPI = false, bool SP2 = false, bool BK8 = false>
__device__ __forceinline__ void gemm_phase(PG8_LAS unsigned char* lds, const Gemm g, const Sched& S, const Epi& E) {
    const int tid = threadIdx.x, wid = __builtin_amdgcn_readfirstlane(tid >> 6), lane = tid & 63, wr = wid >> 2, wc = wid & 3, fr = lane & 15, fq = lane >> 4;
    const int K = g.K, nt = K / BK;
    unsigned voffA[2], voffB[2];
#pragma unroll
    for (int i = 0; i < 2; ++i) { int R, C; stage_rc(tid * 16 + i * 8192, R, C); const int Rb = Epi::PERM ? ((R & ~31) + perm32(R & 31)) : R;
        voffA[i] = (unsigned)(R * K + C) * 2u; voffB[i] = BK8 ? (unsigned)((C >> 3) * g.N + Rb) * 16u : (unsigned)(Rb * K + C) * 2u; }
    const size_t kstepA = (size_t)(BK * 2), hstepA = (size_t)HALF * K * 2, tstepA = 2 * hstepA;
    const size_t kstepB = BK8 ? (size_t)128 * g.N : (size_t)(BK * 2), hstepB = BK8 ? (size_t)2048 : (size_t)HALF * K * 2;
#define PG8_BBASE(u) ((const char*)g.Bt + (BK8 ? (size_t)(u).pe * g.estep + (size_t)(u).pb * 4096 : (size_t)(u).pb * 2 * hstepB))
    const unsigned ldsw = (unsigned)wid * 1024u;
    const int aoff = lds_byte(wr * 64 + fr, fq * 8), boff = lds_byte(wc * 32 + fr, fq * 8);
#define PG8_SA(b, h) (((b) * 2 + (h)) * HTB)
#define PG8_SB(b, h) ((4 + (b) * 2 + (h)) * HTB)
#define PG8_STAGE(bufoff, gbase, voff) do { _Pragma("unroll") for (int _i = 0; _i < 2; ++_i) \
        __builtin_amdgcn_global_load_lds((const unsigned*)((const char*)(gbase) + (voff)[_i]), (PG8_LAS unsigned*)(lds + (bufoff) + ldsw + _i * 8192), 16, 0, 0); } while (0)
#define PG8_LDA(dst, b, h) do { _Pragma("unroll") for (int m = 0; m < 4; ++m) _Pragma("unroll") for (int k = 0; k < 2; ++k) dst[m][k] = *(const PG8_LAS bf16x8*)(lds + PG8_SA(b, h) + aoff + m * 2048 + k * 1024); } while (0)
#define PG8_LDB(dst, b, h) do { _Pragma("unroll") for (int n = 0; n < 2; ++n) _Pragma("unroll") for (int k = 0; k < 2; ++k) dst[n][k] = *(const PG8_LAS bf16x8*)(lds + PG8_SB(b, h) + boff + n * 2048 + k * 1024); } while (0)
#define PG8_MMA(ai, bj, At, Bt) do { __builtin_amdgcn_s_setprio(1); _Pragma("unroll") for (int m = 0; m < 4; ++m) _Pragma("unroll") for (int n = 0; n < 2; ++n) _Pragma("unroll") for (int k = 0; k < 2; ++k) \
        acc[ai][bj][m][n] = __builtin_amdgcn_mfma_f32_16x16x32_bf16(Bt[n][k], At[m][k], acc[ai][bj][m][n], 0, 0, 0); __builtin_amdgcn_s_setprio(0); } while (0)
#define PG8_WAIT_V(n) asm volatile("s_waitcnt vmcnt(" #n ")" ::: "memory")
#define PG8_WAIT_L(n) asm volatile("s_waitcnt lgkmcnt(" #n ")" ::: "memory")
#define PG8_BAR __builtin_amdgcn_s_barrier()
#define PG8_SCHED __builtin_amdgcn_sched_barrier(0)
    Unit cur, nxt; int ui = 0;
    if (!S.next(0, cur)) return;
    f32x4 acc[2][2][4][2];
#pragma unroll
    for (int a = 0; a < 2; ++a)
#pragma unroll
        for (int b = 0; b < 2; ++b)
#pragma unroll
            for (int m = 0; m < 4; ++m)
#pragma unroll
                for (int n = 0; n < 2; ++n) acc[a][b][m][n] = (f32x4){0.f, 0.f, 0.f, 0.f};
    bf16x8 At[4][2], B0[2][2], B1[2][2];
    const char* cA = (const char*)g.A + (size_t)cur.pm * tstepA; const char* cB = PG8_BBASE(cur);
    S.a_ready(cur);
    if constexpr (SP2) {
        PG8_STAGE(PG8_SB(0, 0), cB, voffB); PG8_STAGE(PG8_SB(0, 1), cB + hstepB, voffB); PG8_STAGE(PG8_SA(0, 0), cA, voffA); PG8_STAGE(PG8_SA(0, 1), cA + hstepA, voffA);
        if (wr == 1) PG8_BAR;
        PG8_WAIT_V(2); PG8_BAR;
        PG8_STAGE(PG8_SB(1, 0), cB + kstepB, voffB); PG8_STAGE(PG8_SA(1, 0), cA + kstepA, voffA); PG8_STAGE(PG8_SB(1, 1), cB + hstepB + kstepB, voffB);
        PG8_WAIT_V(6); PG8_BAR;
    } else {
        PG8_STAGE(PG8_SB(0, 0), cB, voffB); PG8_STAGE(PG8_SA(0, 0), cA, voffA); PG8_STAGE(PG8_SB(0, 1), cB + hstepB, voffB); PG8_STAGE(PG8_SA(0, 1), cA + hstepA, voffA);
        if (wr == 1) PG8_BAR;
        PG8_WAIT_V(4); PG8_BAR;
        PG8_STAGE(PG8_SB(1, 0), cB + kstepB, voffB); PG8_STAGE(PG8_SA(1, 0), cA + kstepA, voffA); PG8_STAGE(PG8_SB(1, 1), cB + hstepB + kstepB, voffB);
        PG8_WAIT_V(6); PG8_BAR;
    }
    for (;;) {
        const bool has_next = S.next(ui + 1, nxt);
        const char* nA = has_next ? (const char*)g.A + (size_t)nxt.pm * tstepA : cA; const char* nB = has_next ? PG8_BBASE(nxt) : cB;
        for (int t = 0; t < nt; t += 2) {
            const bool last = (t == nt - 2);
            const char* a1 = cA + (size_t)(t + 1) * kstepA;
            const char* a2 = last ? nA : cA + (size_t)(t + 2) * kstepA; const char* b2 = last ? nB : cB + (size_t)(t + 2) * kstepB;
            const char* a3 = a2 + kstepA; const char* b3 = b2 + kstepB;
            if (last && has_next) S.a_ready(nxt);
            if constexpr (SP2) {
            PG8_LDB(B0, 0, 0); PG8_LDB(B1, 0, 1); PG8_SCHED; PG8_LDA(At, 0, 0); PG8_STAGE(PG8_SA(1, 1), a1 + hstepA, voffA);
            PG8_WAIT_V(8); PG8_WAIT_L(0); PG8_BAR; PG8_MMA(0, 0, At, B0); PG8_MMA(0, 1, At, B1); PG8_BAR; PG8_SCHED;
            PG8_LDA(At, 0, 1); PG8_STAGE(PG8_SB(0, 0), b2, voffB); PG8_STAGE(PG8_SB(0, 1), b2 + hstepB, voffB); PG8_STAGE(PG8_SA(0, 0), a2, voffA);
            PG8_WAIT_V(8); PG8_WAIT_L(0); PG8_BAR; PG8_MMA(1, 0, At, B0); PG8_MMA(1, 1, At, B1); PG8_BAR; PG8_SCHED;
            PG8_LDB(B0, 1, 0); PG8_LDB(B1, 1, 1); PG8_SCHED; PG8_LDA(At, 1, 0); PG8_STAGE(PG8_SA(0, 1), a2 + hstepA, voffA);
            PG8_WAIT_V(8); PG8_WAIT_L(0); PG8_BAR; PG8_MMA(0, 0, At, B0); PG8_MMA(0, 1, At, B1); PG8_BAR; PG8_SCHED;
            PG8_LDA(At, 1, 1); PG8_STAGE(PG8_SB(1, 0), b3, voffB); PG8_STAGE(PG8_SB(1, 1), b3 + hstepB, voffB); PG8_STAGE(PG8_SA(1, 0), a3, voffA);
            PG8_WAIT_V(8); PG8_WAIT_L(0); PG8_BAR; PG8_MMA(1, 0, At, B0); PG8_MMA(1, 1, At, B1); PG8_BAR; PG8_SCHED;
            } else {
            PG8_LDB(B0, 0, 0); PG8_SCHED; PG8_LDA(At, 0, 0); PG8_STAGE(PG8_SA(1, 1), a1 + hstepA, voffA);
            PG8_WAIT_L(8); PG8_BAR; PG8_WAIT_L(0); PG8_MMA(0, 0, At, B0); PG8_BAR; PG8_SCHED;
            PG8_LDB(B1, 0, 1); PG8_STAGE(PG8_SB(0, 0), b2, voffB);
            PG8_BAR; PG8_WAIT_L(0); PG8_MMA(0, 1, At, B1); PG8_BAR;
            PG8_LDA(At, 0, 1); PG8_STAGE(PG8_SA(0, 0), a2, voffA);
            PG8_BAR; PG8_WAIT_L(0); PG8_MMA(1, 0, At, B0); PG8_BAR; PG8_SCHED;
            PG8_STAGE(PG8_SB(0, 1), b2 + hstepB, voffB);
            PG8_WAIT_V(6); PG8_BAR; PG8_MMA(1, 1, At, B1); PG8_BAR;
            PG8_LDB(B0, 1, 0); PG8_SCHED; PG8_LDA(At, 1, 0); PG8_STAGE(PG8_SA(0, 1), a2 + hstepA, voffA);
            PG8_WAIT_L(8); PG8_BAR; PG8_WAIT_L(0); PG8_MMA(0, 0, At, B0); PG8_BAR; PG8_SCHED;
            PG8_LDB(B1, 1, 1); PG8_STAGE(PG8_SB(1, 0), b3, voffB);
            PG8_BAR; PG8_WAIT_L(0); PG8_MMA(0, 1, At, B1); PG8_BAR;
            PG8_LDA(At, 1, 1); PG8_STAGE(PG8_SA(1, 0), a3, voffA);
            PG8_BAR; PG8_WAIT_L(0); PG8_MMA(1, 0, At, B0); PG8_BAR; PG8_SCHED;
            PG8_STAGE(PG8_SB(1, 1), b3 + hstepB, voffB);
            PG8_WAIT_V(6); PG8_BAR; PG8_MMA(1, 1, At, B1); PG8_BAR;
            }
        }
        if constexpr (ALIGN_EPI) { if (wr == 0) PG8_BAR; }
        if constexpr (!Epi::AFTER_DRAIN) { E(acc, cur, wr, wc, fr, fq); S.done(cur, ui); }
        if (!has_next) break;
#pragma unroll
        for (int a = 0; a < 2; ++a)
#pragma unroll
            for (int b = 0; b < 2; ++b)
#pragma unroll
                for (int m = 0; m < 4; ++m)
#pragma unroll
                    for (int n = 0; n < 2; ++n) acc[a][b][m][n] = (f32x4){0.f, 0.f, 0.f, 0.f};
        cur = nxt; cA = nA; cB = nB; ++ui;
        if constexpr (ALIGN_EPI) { if (wr == 1) PG8_BAR; }
    }
    PG8_WAIT_V(0);
    if constexpr (!ALIGN_EPI) { if (wr == 0) PG8_BAR; }
    PG8_BAR;
    if constexpr (Epi::AFTER_DRAIN) { E.fused(acc, cur, wr, wc, fr, fq, lds, wid, lane); S.done(cur, ui); }
#undef PG8_BBASE
#undef PG8_SA
#undef PG8_SB
#undef PG8_STAGE
#undef PG8_LDA
#undef PG8_LDB
#undef PG8_MMA
#undef PG8_WAIT_V
#undef PG8_WAIT_L
#undef PG8_BAR
#undef PG8_SCHED
}
}
#define XB_TMO      128
#define XB_XCNT(j)  (256  + 64 * (j))
#define XB_XSUB(j)  (1280 + 64 * (j))
#define XB_XGEN(j)  (2304 + 64 * (j))
#define XB_TOP      3328
#define XB_TOPGEN   3392
#define XCD_BAR_WORDS 3456
#define XB_SPIN_CAP (1u << 18)
#define LAS __attribute__((address_space(3)))

__device__ __forceinline__ unsigned xb_ld(unsigned* p)              { return __hip_atomic_load(p, __ATOMIC_RELAXED, __HIP_MEMORY_SCOPE_AGENT); }
__device__ __forceinline__ unsigned xb_add(unsigned* p, unsigned v) { return __hip_atomic_fetch_add(p, v, __ATOMIC_RELAXED, __HIP_MEMORY_SCOPE_AGENT); }
__device__ __forceinline__ unsigned xb_xcc_id() { return (unsigned)__builtin_amdgcn_s_getreg((3 << 11) | 20) & 0xFu; }
#define XB_SPIN(cond, bar) do { unsigned _sp = 0; while (cond) { __builtin_amdgcn_s_sleep(1); \
    if ((++_sp & 255u) == 0u) { if (xb_ld(&(bar)[XB_TMO])) break; if (_sp > XB_SPIN_CAP) { atomicAdd(&(bar)[XB_TMO], 1u); break; } } } } while (0)

struct XcdBarrier {
    unsigned* bar; unsigned x;
    volatile LAS unsigned* st;
};

__device__ __forceinline__ XcdBarrier xcd_barrier_post(unsigned* bar, volatile LAS unsigned* st) {
    XcdBarrier b; b.bar = bar; b.x = xb_xcc_id(); b.st = st;
    if (threadIdx.x == 0) (void)xb_add(&bar[XB_XCNT(b.x)], 1u);
    return b;
}
__device__ __forceinline__ void xcd_barrier_complete(unsigned* bar, unsigned x, unsigned& nloc, unsigned& nx) {
    const unsigned G = gridDim.x * gridDim.y * gridDim.z;
    unsigned sum, cnt, mine, sp = 0u;
    for (;;) {
        sum = 0u; cnt = 0u; mine = 0u;
#pragma unroll
        for (unsigned j = 0; j < 16; ++j) { const unsigned c = xb_ld(&bar[XB_XCNT(j)]); sum += c; cnt += (c > 0u) ? 1u : 0u; mine = (j == x) ? c : mine; }
        if (sum == G) break;
        __builtin_amdgcn_s_sleep(1);
        if ((++sp & 255u) == 0u) { if (xb_ld(&bar[XB_TMO])) break; if (sp > XB_SPIN_CAP) { atomicAdd(&bar[XB_TMO], 1u); break; } }
    }
    nloc = mine > 0u ? mine : 1u; nx = cnt > 0u ? cnt : 1u;
}

__device__ __forceinline__ void xcd_barrier(const XcdBarrier& b) {
    asm volatile("s_waitcnt vmcnt(0)" ::: "memory");
    __syncthreads();
    if (threadIdx.x == 0) {
        unsigned* bar = b.bar;
        __builtin_amdgcn_s_waitcnt(0);
        unsigned nloc = b.st[0], nx = b.st[1];
        if (nloc == 0u) { xcd_barrier_complete(bar, b.x, nloc, nx); b.st[0] = nloc; b.st[1] = nx; }
        const unsigned old = xb_add(&bar[XB_XSUB(b.x)], 1u);
        const unsigned gen = old / nloc;
        if (old + 1u == (gen + 1u) * nloc) {
            __builtin_amdgcn_fence(__ATOMIC_RELEASE, "agent");
            asm volatile("s_waitcnt vmcnt(0)" ::: "memory");
            const unsigned og = xb_add(&bar[XB_TOP], 1u);
            const unsigned tg = og / nx;
            if (og + 1u == (tg + 1u) * nx) xb_add(&bar[XB_TOPGEN], 1u);
            else XB_SPIN(xb_ld(&bar[XB_TOPGEN]) == tg, bar);
            __builtin_amdgcn_fence(__ATOMIC_ACQUIRE, "agent");
            xb_add(&bar[XB_XGEN(b.x)], 1u);
            asm volatile("s_waitcnt vmcnt(0)" ::: "memory");
        } else {
            XB_SPIN(xb_ld(&bar[XB_XGEN(b.x)]) == gen, bar);
            __builtin_amdgcn_fence(__ATOMIC_ACQUIRE, "agent");
            asm volatile("s_waitcnt vmcnt(0)" ::: "memory");
        }
    }
    __syncthreads();
}

constexpr int T = 16384, D = 2048, NTHR = 512, NWAVES = 8;
constexpr int NU = 5632;
constexpr int N_IN = 5648, N_IN_PAD = 5888;
constexpr int NCHUNK = 256;
constexpr int NE = 32, FF = 1024;
constexpr int MAX_TILES = 160;
constexpr float EPS = 1e-6f;
enum { IN_X = 0, IN_C, IN_WADA, IN_BADA, IN_N1W, IN_WIN, IN_CONVW, IN_SCONVW, IN_SCONVB, IN_DTB, IN_ALOG, IN_DSKIP, IN_SNW, IN_WOUT, IN_N2W, IN_WRG, IN_BRG, IN_WRE, IN_BRE, IN_WG, IN_WU, IN_WD, IN_FNW, N_INPUTS };

constexpr size_t KiB = 1024, MiB = 1u << 20;
constexpr size_t WS_CTL = 0, CTL_ZERO_BYTES = 1 * MiB;
constexpr size_t WS_MOD = 1 * MiB;
constexpr size_t WS_BIAS2 = 1 * MiB + 56 * KiB;
constexpr size_t WS_W2T = 1 * MiB + 64 * KiB;
constexpr size_t WS_BLKCNT = 1536 * KiB;
constexpr size_t WS_TILE = 1600 * KiB;
constexpr size_t WS_SLOT = 1664 * KiB;
constexpr size_t WS_EW = 1792 * KiB;
constexpr size_t WS_EID = 1920 * KiB;
constexpr size_t WS_RANK = 5 * MiB;
constexpr size_t WS_DT = 2 * MiB, WS_ACS = 3 * MiB, WS_UDT = 4 * MiB;
constexpr size_t WS_WIN = 8 * MiB;
constexpr size_t WS_WOUT = 32 * MiB;
constexpr size_t WS_WGU = 40 * MiB;
constexpr size_t WS_WD = 296 * MiB;
constexpr size_t WS_H = 424 * MiB;
constexpr size_t WS_U = 488 * MiB;
constexpr size_t WS_YMIX = 664 * MiB;
constexpr size_t WS_XS = 744 * MiB;
constexpr size_t WS_BM = 776 * MiB, WS_CM = 784 * MiB;
constexpr size_t WS_ST = 792 * MiB;
constexpr size_t WS_BMT = 856 * MiB;
constexpr size_t WS_YB = 744 * MiB;
constexpr size_t WS_END = 904 * MiB;
constexpr int CW_DBG = 16;
constexpr int CW_BAR = 4096;

constexpr int RING_BYTES = 131072;
constexpr int MISC_OFF = 131072;
constexpr int LDS_BYTES = 131072 + 1024;

#define GAS __attribute__((address_space(1)))
typedef unsigned short bf16;
typedef unsigned v4u __attribute__((ext_vector_type(4)));
typedef unsigned v2u __attribute__((ext_vector_type(2)));
typedef float f32x4 __attribute__((ext_vector_type(4)));
#define LDS_WAIT() asm volatile("s_waitcnt lgkmcnt(0)" ::: "memory")
__device__ __forceinline__ float bflo(unsigned u) { return __builtin_bit_cast(float, u << 16); }
__device__ __forceinline__ float bfhi(unsigned u) { return __builtin_bit_cast(float, u & 0xffff0000u); }
__device__ __forceinline__ unsigned pk2(float lo, float hi) { return pg8::cvt_pk_bf16(lo, hi); }
__device__ __forceinline__ float wave_sum(float v) {
#pragma unroll
    for (int o = 1; o < 64; o <<= 1) v += __shfl_xor(v, o);
    return v;
}
__device__ __forceinline__ float silu_f(float v) { return v / (1.f + __expf(-v)); }

struct Args { const float* in[N_INPUTS]; float* out; unsigned char* ws; int ph_lo, ph_hi, li, pad; };

struct Frame {
    LAS unsigned char* lds;
    int tid, lane, wave, G, vcu, bid;
    unsigned char* ws;
};

struct ConvJob { const float* wg; const float* wu; const float* wd; bf16* dgu; bf16* dd; };
struct K8Item { const float* src; bf16* dst; int ldw, rowadd, gate_like; };
__device__ __forceinline__ K8Item k8_decode(const ConvJob& J, int id, int lane) {
    K8Item t;
    if (id < 65536) { const int up = id >> 15, r0 = id & 32767, e = r0 >> 10, r = r0 & 1023, kb = r >> 2, nb = r & 3;
        t.src = (up ? J.wu : J.wg) + (size_t)e * D * FF + (size_t)(kb * 8) * FF + nb * 256 + lane; t.ldw = FF;
        t.dst = J.dgu + (size_t)e * 2048 * D + (size_t)kb * 2048 * 8; t.rowadd = (up ? 128 : 0) + nb * 512; t.gate_like = 1; }
    else { const int r0 = id - 65536, e = r0 >> 10, r = r0 & 1023, kb = r >> 3, nb = r & 7;
        t.src = J.wd + (size_t)e * FF * D + (size_t)(kb * 8) * D + nb * 256 + lane; t.ldw = D;
        t.dst = J.dd + (size_t)e * 2048 * FF + (size_t)kb * 2048 * 8; t.rowadd = nb * 256; t.gate_like = 0; }
    return t;
}
#define K8_LOAD(v, t, h) do { _Pragma("unroll") for (int g = 0; g < 2; ++g) _Pragma("unroll") for (int i = 0; i < 8; ++i) v[g][i] = (t).src[(size_t)i * (t).ldw + 64 * (2 * (h) + g)]; } while (0)
#define K8_STORE(v, t, h) do { _Pragma("unroll") for (int g = 0; g < 2; ++g) { const int c_ = 64 * (2 * (h) + g) + lane; const int row_ = (t).rowadd + ((t).gate_like ? ((c_ >> 7) << 8) + (c_ & 127) : c_); \
        v4u o_; o_.x = pk2(v[g][0], v[g][1]); o_.y = pk2(v[g][2], v[g][3]); o_.z = pk2(v[g][4], v[g][5]); o_.w = pk2(v[g][6], v[g][7]); *(v4u*)((t).dst + (size_t)row_ * 8) = o_; } } while (0)
__device__ __forceinline__ void k8_convert(const ConvJob& J, int it0, int nit, int lane) {
    if (nit <= 0) return;
    float va[2][8], vb[2][8];
    K8Item t = k8_decode(J, it0, lane);
    K8_LOAD(va, t, 0);
#pragma unroll 1
    for (int id = it0; id < it0 + nit; ++id) {
        K8_LOAD(vb, t, 1);
        K8_STORE(va, t, 0);
        const K8Item tn = k8_decode(J, (id + 1 < it0 + nit) ? id + 1 : id, lane);
        K8_LOAD(va, tn, 0);
        K8_STORE(vb, t, 1);
        t = tn;
    }
}
#undef K8_LOAD
#undef K8_STORE
struct ConvOrder : pg8::StaticOrder {
    ConvJob J; int pos, it0, nit;
    __device__ __forceinline__ void done(const pg8::Unit&, int ui) const { if (ui == pos) k8_convert(J, it0, nit, (int)(threadIdx.x & 63)); }
};

__device__ __forceinline__ void p0_ada(const Frame& F, const float* cvec, const float* w_ada, const float* b_ada, float* mod) {
    LAS float* red = (LAS float*)F.lds;
    const int kq = F.tid / 12, cq = F.tid % 12;
    for (int chunk = F.vcu; chunk < 256; chunk += F.G) {
        if (F.tid < 504) {
            f32x4 acc = (f32x4){0.f, 0.f, 0.f, 0.f};
            const float* wp = w_ada + 48 * chunk + 4 * cq;
#pragma unroll 7
            for (int i = 0; i < 49; ++i) {
                const int k = kq + 42 * i; const bool ok = k < D; const int kk = ok ? k : 0;
                const float cv = cvec[kk]; const float s = ok ? cv / (1.f + expf(-cv)) : 0.f;
                const f32x4 w = *(const f32x4*)(wp + (size_t)kk * 12288);
                acc += s * w;
            }
            *(LAS f32x4*)(red + kq * 48 + 4 * cq) = acc;
        }
        __syncthreads();
        if (F.tid < 48) { float s = 0.f; for (int q = 0; q < 42; ++q) s += red[q * 48 + F.tid]; mod[48 * chunk + F.tid] = s + b_ada[48 * chunk + F.tid]; }
        __syncthreads();
    }
}
__device__ __forceinline__ void tr_item(const float* W, int ldw, int nvalid, int k0, int n0, bf16* dst, int ldd, LAS float* scr, int lane) {
    const int nn = n0 + (lane & 31); const bool ok = nn < nvalid; const int nc = ok ? nn : 0;
#pragma unroll 8
    for (int i = 0; i < 32; ++i) { const int kk = 2 * i + (lane >> 5); const float v = W[(size_t)(k0 + kk) * ldw + nc]; scr[kk * 33 + (lane & 31)] = ok ? v : 0.f; }
    LDS_WAIT();
    const int c = lane & 7;
#pragma unroll
    for (int j = 0; j < 4; ++j) { const int n = (lane >> 3) + 8 * j; const LAS float* s = scr + (8 * c) * 33 + n;
        v4u o; o.x = pk2(s[0 * 33], s[1 * 33]); o.y = pk2(s[2 * 33], s[3 * 33]); o.z = pk2(s[4 * 33], s[5 * 33]); o.w = pk2(s[6 * 33], s[7 * 33]);
        *(v4u*)(dst + (size_t)n * ldd + k0 + 8 * c) = o; }
    LDS_WAIT();
}
__device__ __forceinline__ void p0_convert(const Frame& F, const Args& a) {
    LAS float* scr = (LAS float*)(F.lds + 16384 + F.wave * 8704);
    bf16* Wt_in = (bf16*)(F.ws + WS_WIN); bf16* Wt_out = (bf16*)(F.ws + WS_WOUT);
    constexpr int I_IN = 32 * 177, I_OUT = 32 * 64, NITEMS = I_IN + I_OUT;
    const int gw = F.bid * NWAVES + F.wave, NGW = F.G * NWAVES;
    for (int it = gw; it < NITEMS; it += NGW) {
        int r = it;
        if (r < I_IN) { const int kb = r / 177, nb = r % 177; tr_item(a.in[IN_WIN], N_IN, N_IN, 64 * kb, 32 * nb, Wt_in + (size_t)(32 * nb) * D, D, scr, F.lane); continue; } r -= I_IN;
        { const int kb = r / 64, nb = r % 64; tr_item(a.in[IN_WOUT], D, D, 64 * kb, 32 * nb, Wt_out + (size_t)(32 * nb) * D, D, scr, F.lane); }
    }
    v4u* z = (v4u*)(Wt_in + (size_t)5664 * D); const int nz = 224 * D * 2 / 16;
    for (int i = F.bid * NTHR + F.tid; i < nz; i += F.G * NTHR) z[i] = (v4u){0u, 0u, 0u, 0u};
}

__device__ __forceinline__ void norm_rows(const Frame& F, const float* X, const float* nw, const float* sc, const float* sh, bf16* H) {
    f32x4 av[8], sv[8];
#pragma unroll
    for (int j = 0; j < 8; ++j) { const int k = 4 * F.lane + 256 * j; const f32x4 w = *(const f32x4*)(nw + k), s = *(const f32x4*)(sc + k); av[j] = w * (s + 1.f); sv[j] = *(const f32x4*)(sh + k); }
    const int gw = F.bid * NWAVES + F.wave, NGW = F.G * NWAVES;
    f32x4 nx[8];
    if (gw < T) {
#pragma unroll
        for (int j = 0; j < 8; ++j) nx[j] = ((const f32x4*)(X + (size_t)gw * D) + F.lane)[64 * j]; }
    for (int row = gw; row < T; row += NGW) {
        f32x4 v[8]; float s = 0.f;
#pragma unroll
        for (int j = 0; j < 8; ++j) { v[j] = nx[j]; s += (v[j].x * v[j].x + v[j].y * v[j].y) + (v[j].z * v[j].z + v[j].w * v[j].w); }
        if (row + NGW < T) {
#pragma unroll
            for (int j = 0; j < 8; ++j) nx[j] = ((const f32x4*)(X + (size_t)(row + NGW) * D) + F.lane)[64 * j]; }
        const float rstd = 1.f / sqrtf(wave_sum(s) * (1.f / D) + EPS);
        v2u* o = (v2u*)(H + (size_t)row * D) + F.lane;
#pragma unroll
        for (int j = 0; j < 8; ++j) { const f32x4 h = v[j] * rstd * av[j] + sv[j]; v2u w; w.x = pk2(h.x, h.y); w.y = pk2(h.z, h.w); o[64 * j] = w; }
    }
}
__device__ __forceinline__ void p1_router_prep(const Frame& F, const Args& a) {
    const float* mod = (const float*)(F.ws + WS_MOD); const float* sh2 = mod + 3 * D; const float* sc2 = mod + 4 * D;
    float* w2t = (float*)(F.ws + WS_W2T); float* bias2 = (float*)(F.ws + WS_BIAS2);
    const float* wrg = a.in[IN_WRG]; const float* wre = a.in[IN_WRE]; const float* n2w = a.in[IN_N2W];
    for (int i = F.bid * NTHR + F.tid; i < 48 * D; i += F.G * NTHR) {
        const int c = i / D, k = i % D; float v = 0.f;
        if (c < 36) { const float w = c < 4 ? wrg[k * 4 + c] : wre[k * 32 + (c - 4)]; v = w * n2w[k] * (1.f + sc2[k]); }
        w2t[i] = v;
    }
    if (F.bid == 0) {
        for (int c = F.wave; c < 48; c += NWAVES) { float s = 0.f;
            if (c < 36) { for (int k = F.lane; k < D; k += 64) { const float w = c < 4 ? wrg[k * 4 + c] : wre[k * 32 + (c - 4)]; s += sh2[k] * w; } s = wave_sum(s); s += c < 4 ? a.in[IN_BRG][c] : a.in[IN_BRE][c - 4]; }
            if (F.lane == 0) bias2[c] = s; }
    }
}

typedef short bf16x8 __attribute__((ext_vector_type(8)));
__device__ __forceinline__ f32x4 mma16(bf16x8 a, bf16x8 b, f32x4 c) { return __builtin_amdgcn_mfma_f32_16x16x32_bf16(a, b, c, 0, 0, 0); }
__device__ __forceinline__ void unpack8(const v4u u, float (&f)[8]) {
#pragma unroll
    for (int q = 0; q < 4; ++q) { f[2 * q] = bflo(u[q]); f[2 * q + 1] = bfhi(u[q]); } }
__device__ __forceinline__ v4u pack8(const float (&f)[8]) { v4u o; o.x = pk2(f[0], f[1]); o.y = pk2(f[2], f[3]); o.z = pk2(f[4], f[5]); o.w = pk2(f[6], f[7]); return o; }
__device__ __forceinline__ int xt_off(int ch, int q) { return ch * 128 + ((q ^ (((ch >> 3) ^ ch) & 7)) << 4); }

__device__ __forceinline__ void p3_chunk(const Frame& F, const Args& a, int c) {
    int tz = F.tid; asm volatile("" : "+v"(tz));
    const int t0 = c * 64, tid = tz;
    const bf16* U = (const bf16*)(F.ws + WS_U); bf16* ymix = (bf16*)(F.ws + WS_YMIX);
    bf16* xsTg = (bf16*)(F.ws + WS_XS); bf16* Bm = (bf16*)(F.ws + WS_BM); bf16* Cm = (bf16*)(F.ws + WS_CM); bf16* BmTg = (bf16*)(F.ws + WS_BMT);
    const float* cw4 = a.in[IN_SCONVW]; const float* cb4 = a.in[IN_SCONVB];
    const v4u vzero = (v4u){0u, 0u, 0u, 0u};
    {
        const int sg = tid >> 6, cgB = tid & 63, chx = 1024 + 8 * cgB;
        v4u ub[11];
#pragma unroll
        for (int i = 0; i < 11; ++i) { const int t = t0 + 8 * sg - 3 + i; ub[i] = (t >= 0) ? *(const v4u*)(U + (size_t)t * NU + 4096 + chx) : vzero; }
        float w[4][8], bia[8];
#pragma unroll
        for (int j = 0; j < 4; ++j) { const f32x4 w0 = *(const f32x4*)(cw4 + j * 1536 + chx), w1 = *(const f32x4*)(cw4 + j * 1536 + chx + 4);
#pragma unroll
            for (int k = 0; k < 4; ++k) { w[j][k] = w0[k]; w[j][4 + k] = w1[k]; } }
        { const f32x4 b0 = *(const f32x4*)(cb4 + chx), b1 = *(const f32x4*)(cb4 + chx + 4);
#pragma unroll
            for (int k = 0; k < 4; ++k) { bia[k] = b0[k]; bia[4 + k] = b1[k]; } }
        float p3[8], p2[8], p1[8]; unpack8(ub[0], p3); unpack8(ub[1], p2); unpack8(ub[2], p1);
        float ye[8]; unsigned trp[8][4];
#pragma unroll
        for (int m = 0; m < 8; ++m) {
            float x[8], y[8]; unpack8(ub[3 + m], x);
#pragma unroll
            for (int k = 0; k < 8; ++k) { y[k] = silu_f(w[0][k] * p3[k] + w[1][k] * p2[k] + w[2][k] * p1[k] + w[3][k] * x[k] + bia[k]); p3[k] = p2[k]; p2[k] = p1[k]; p1[k] = x[k]; }
            const v4u o = pack8(y);
            if (cgB < 32) *(v4u*)(Bm + (size_t)(t0 + 8 * sg + m) * 256 + 8 * cgB) = o; else *(v4u*)(Cm + (size_t)(t0 + 8 * sg + m) * 256 + 8 * (cgB - 32)) = o;
            if (m & 1) {
#pragma unroll
                for (int k = 0; k < 8; ++k) trp[k][m >> 1] = pk2(ye[k], y[k]); }
            else {
#pragma unroll
                for (int k = 0; k < 8; ++k) ye[k] = y[k]; }
        }
        if (cgB < 32) {
#pragma unroll
            for (int k = 0; k < 8; ++k) *(v4u*)(BmTg + ((size_t)c * 256 + 8 * cgB + k) * 64 + 8 * sg) = (v4u){trp[k][0], trp[k][1], trp[k][2], trp[k][3]}; }
    }
    const int seg = tid >> 7, cg = tid & 127;
    {
        v4u ux[11], ux2[8];
#pragma unroll
        for (int i = 0; i < 11; ++i) { const int t = t0 + 16 * seg - 3 + i; ux[i] = (t >= 0) ? *(const v4u*)(U + (size_t)t * NU + 4096 + 8 * cg) : vzero; }
        float w[4][8], bia[8];
#pragma unroll
        for (int j = 0; j < 4; ++j) { const f32x4 w0 = *(const f32x4*)(cw4 + j * 1536 + 8 * cg), w1 = *(const f32x4*)(cw4 + j * 1536 + 8 * cg + 4);
#pragma unroll
            for (int k = 0; k < 4; ++k) { w[j][k] = w0[k]; w[j][4 + k] = w1[k]; } }
        { const f32x4 b0 = *(const f32x4*)(cb4 + 8 * cg), b1 = *(const f32x4*)(cb4 + 8 * cg + 4);
#pragma unroll
            for (int k = 0; k < 4; ++k) { bia[k] = b0[k]; bia[4 + k] = b1[k]; } }
        float p3[8], p2[8], p1[8]; unpack8(ux[0], p3); unpack8(ux[1], p2); unpack8(ux[2], p1);
#pragma unroll
        for (int hf = 0; hf < 2; ++hf) {
            float ye[8]; unsigned trp[8][4];
            if (hf == 0) {
#pragma unroll
                for (int i = 0; i < 8; ++i) ux2[i] = *(const v4u*)(U + (size_t)(t0 + 16 * seg + 8 + i) * NU + 4096 + 8 * cg); }
#pragma unroll
            for (int m = 0; m < 8; ++m) {
                float x[8], y[8]; unpack8(hf == 0 ? ux[3 + m] : ux2[m], x);
#pragma unroll
                for (int k = 0; k < 8; ++k) { y[k] = silu_f(w[0][k] * p3[k] + w[1][k] * p2[k] + w[2][k] * p1[k] + w[3][k] * x[k] + bia[k]); p3[k] = p2[k]; p2[k] = p1[k]; p1[k] = x[k]; }
                if (m & 1) {
#pragma unroll
                    for (int k = 0; k < 8; ++k) trp[k][m >> 1] = pk2(ye[k], y[k]); }
                else {
#pragma unroll
                    for (int k = 0; k < 8; ++k) ye[k] = y[k]; }
            }
#pragma unroll
            for (int k = 0; k < 8; ++k) *(LAS v4u*)(F.lds + xt_off(8 * cg + k, 2 * seg + hf)) = (v4u){trp[k][0], trp[k][1], trp[k][2], trp[k][3]};
        }
    }
    {
        const float* cw = a.in[IN_CONVW];
        float w[3][8];
#pragma unroll
        for (int j = 0; j < 3; ++j) { const f32x4 w0 = *(const f32x4*)(cw + j * 1024 + 8 * cg), w1 = *(const f32x4*)(cw + j * 1024 + 8 * cg + 4);
#pragma unroll
            for (int k = 0; k < 4; ++k) { w[j][k] = w0[k]; w[j][4 + k] = w1[k]; } }
        float p2[8], p1[8];
#pragma unroll
        for (int k = 0; k < 8; ++k) { p2[k] = 0.f; p1[k] = 0.f; }
#pragma unroll 1
        for (int bt = 0; bt < 3; ++bt) {
            v4u uB[6], uC[6], uV[6];
#pragma unroll
            for (int i = 0; i < 6; ++i) { const int tl = 16 * seg - 2 + 6 * bt + i, t = t0 + tl; const bool ok = t >= 0;
                const bf16* ur = U + (size_t)(ok ? t : 0) * NU + 8 * cg;
                uC[i] = ok ? *(const v4u*)(ur + 1024) : vzero; uV[i] = ok ? *(const v4u*)(ur + 2048) : vzero; uB[i] = *(const v4u*)(ur); }
#pragma unroll
            for (int i = 0; i < 6; ++i) {
                float cf[8], vf[8], cv[8]; unpack8(uC[i], cf); unpack8(uV[i], vf);
#pragma unroll
                for (int k = 0; k < 8; ++k) cv[k] = cf[k] * vf[k];
                if (6 * bt + i >= 2) { float bf_[8], y[8]; unpack8(uB[i], bf_);
#pragma unroll
                    for (int k = 0; k < 8; ++k) y[k] = bf_[k] * (w[0][k] * p2[k] + w[1][k] * p1[k] + w[2][k] * cv[k]);
                    *(v4u*)(ymix + (size_t)(t0 + 16 * seg - 2 + 6 * bt + i) * D + 8 * cg) = pack8(y); }
#pragma unroll
                for (int k = 0; k < 8; ++k) { p2[k] = p1[k]; p1[k] = cv[k]; }
            }
        }
    }
    float* dtT = (float*)(F.ws + WS_DT); float* acsT = (float*)(F.ws + WS_ACS); const float* udt = (const float*)(F.ws + WS_UDT);
#pragma unroll
    for (int hi = 0; hi < 2; ++hi) {
        const int h = F.wave + 8 * hi; const float bias = a.in[IN_DTB][h], A = -expf(a.in[IN_ALOG][h]);
        const int ln = tid & 63; const float x = udt[(size_t)(t0 + ln) * 16 + h] + bias; const float dt = fmaxf(x, 0.f) + log1pf(expf(-fabsf(x)));
        float cs = A * dt;
#pragma unroll
        for (int o = 1; o < 64; o <<= 1) { const float v = __shfl_up(cs, o); cs += (ln >= o) ? v : 0.f; }
        dtT[((size_t)c * 16 + h) * 64 + ln] = dt; acsT[((size_t)c * 16 + h) * 64 + ln] = cs;
    }
    asm volatile("s_waitcnt vmcnt(0)" ::: "memory");
    __syncthreads();
#pragma unroll 4
    for (int it = 0; it < 16; ++it) { const int p = tid + NTHR * it; *(v4u*)(xsTg + (size_t)c * 65536 + (size_t)p * 8) = *(const LAS v4u*)(F.lds + xt_off(p >> 3, p & 7)); }
    const bf16* BmT = (const bf16*)(F.ws + WS_BMT); bf16* st = (bf16*)(F.ws + WS_ST);
    const int fr = tid & 15, fq = (tid >> 4) & 3;
#pragma unroll 1
    for (int hi = 0; hi < 2; ++hi) {
        const int h = F.wave + 8 * hi, g = h >> 3;
        const float* dT = dtT + ((size_t)c * 16 + h) * 64; const float* aT = acsT + ((size_t)c * 16 + h) * 64; const float a63 = aT[63];
        bf16x8 xb[4][2];
#pragma unroll
        for (int ks = 0; ks < 2; ++ks) {
            const f32x4 d0 = *(const f32x4*)(dT + 32 * ks + 8 * fq), d1 = *(const f32x4*)(dT + 32 * ks + 8 * fq + 4), a0 = *(const f32x4*)(aT + 32 * ks + 8 * fq), a1 = *(const f32x4*)(aT + 32 * ks + 8 * fq + 4);
            float w[8];
#pragma unroll
            for (int j = 0; j < 4; ++j) { w[j] = d0[j] * __expf(a63 - a0[j]); w[4 + j] = d1[j] * __expf(a63 - a1[j]); }
#pragma unroll
            for (int nb = 0; nb < 4; ++nb) { const v4u raw = *(const LAS v4u*)(F.lds + xt_off(h * 64 + nb * 16 + fr, 4 * ks + fq)); v4u sc;
#pragma unroll
                for (int q = 0; q < 4; ++q) sc[q] = pk2(bflo(raw[q]) * w[2 * q], bfhi(raw[q]) * w[2 * q + 1]);
                xb[nb][ks] = __builtin_bit_cast(bf16x8, sc); }
        }
#pragma unroll 1
        for (int half = 0; half < 2; ++half) {
            f32x4 acc[4][4];
#pragma unroll
            for (int mb = 0; mb < 4; ++mb)
#pragma unroll
                for (int nb = 0; nb < 4; ++nb) acc[mb][nb] = (f32x4){0.f, 0.f, 0.f, 0.f};
#pragma unroll
            for (int ks = 0; ks < 2; ++ks)
#pragma unroll
                for (int mb = 0; mb < 4; ++mb) { const bf16x8 av = *(const bf16x8*)(BmT + ((size_t)c * 256 + g * 128 + half * 64 + mb * 16 + fr) * 64 + 32 * ks + 8 * fq);
#pragma unroll
                    for (int nb = 0; nb < 4; ++nb) acc[mb][nb] = mma16(av, xb[nb][ks], acc[mb][nb]); }
#pragma unroll
            for (int mb = 0; mb < 4; ++mb)
#pragma unroll
                for (int nb = 0; nb < 4; ++nb) { v2u w; w.x = pk2(acc[mb][nb][0], acc[mb][nb][1]); w.y = pk2(acc[mb][nb][2], acc[mb][nb][3]);
                    *(v2u*)(st + (((size_t)c * 16 + h) * 64 + nb * 16 + fr) * 128 + half * 64 + mb * 16 + 4 * fq) = w; }
        }
    }
    __syncthreads();
}

__device__ __forceinline__ void p_scan(const Frame& F) {
    bf16* st = (bf16*)(F.ws + WS_ST); const float* acsT = (const float*)(F.ws + WS_ACS);
    for (int e = F.bid * NTHR + F.tid; e < 16 * 64 * 128; e += F.G * NTHR) {
        const int head = e >> 13; float h = 0.f;
#pragma unroll 1
        for (int cb = 0; cb < NCHUNK; cb += 32) {
            unsigned short sv[32]; float dv[32];
#pragma unroll
            for (int i = 0; i < 32; ++i) { sv[i] = st[(size_t)(cb + i) * 131072 + e]; dv[i] = acsT[((size_t)(cb + i) * 16 + head) * 64 + 63]; }
#pragma unroll
            for (int i = 0; i < 32; ++i) { st[(size_t)(cb + i) * 131072 + e] = (bf16)(pk2(h, 0.f) & 0xffffu); h = h * __expf(dv[i]) + bflo((unsigned)sv[i]); }
        }
    }
}

__device__ __forceinline__ void p4_unit(const Frame& F, const Args& a, int c, int g) {
    const int t0 = c * 64, hh = F.wave, h = g * 8 + hh, fr = F.lane & 15, fq = F.lane >> 4;
    const bf16* U = (const bf16*)(F.ws + WS_U); bf16* ymix = (bf16*)(F.ws + WS_YMIX);
    const bf16* xsT = (const bf16*)(F.ws + WS_XS); const bf16* Bm = (const bf16*)(F.ws + WS_BM); const bf16* Cm = (const bf16*)(F.ws + WS_CM);
    const float* dT = (const float*)(F.ws + WS_DT) + ((size_t)c * 16 + h) * 64; const float* aT = (const float*)(F.ws + WS_ACS) + ((size_t)c * 16 + h) * 64;
    const bf16* pv = (const bf16*)(F.ws + WS_ST) + ((size_t)c * 16 + h) * 64 * 128;
    LAS unsigned char* mbuf = F.lds + hh * 9216;
    LAS float* sred = (LAS float*)(F.lds + 73728);
    LAS float* srs = (LAS float*)(F.lds + 75776);
    float al[4];
#pragma unroll
    for (int nb = 0; nb < 4; ++nb) al[nb] = aT[nb * 16 + fr];
    bf16x8 cf[4][4];
#pragma unroll
    for (int nb = 0; nb < 4; ++nb)
#pragma unroll
        for (int ks = 0; ks < 4; ++ks) cf[nb][ks] = *(const bf16x8*)(Cm + (size_t)(t0 + nb * 16 + fr) * 256 + g * 128 + 32 * ks + 8 * fq);
    f32x4 acc[4][4];
#pragma unroll
    for (int mb = 0; mb < 4; ++mb)
#pragma unroll
        for (int nb = 0; nb < 4; ++nb) acc[mb][nb] = (f32x4){0.f, 0.f, 0.f, 0.f};
#pragma unroll
    for (int ks = 0; ks < 4; ++ks)
#pragma unroll
        for (int mb = 0; mb < 4; ++mb) { const bf16x8 bv = *(const bf16x8*)(Bm + (size_t)(t0 + mb * 16 + fr) * 256 + g * 128 + 32 * ks + 8 * fq);
#pragma unroll
            for (int nb = 0; nb < 4; ++nb) acc[mb][nb] = mma16(bv, cf[nb][ks], acc[mb][nb]); }
    {
        const float dsk = a.in[IN_DSKIP][h];
#pragma unroll
        for (int mb = 0; mb < 4; ++mb) { const f32x4 as = *(const f32x4*)(aT + mb * 16 + 4 * fq), ds = *(const f32x4*)(dT + mb * 16 + 4 * fq);
#pragma unroll
            for (int nb = 0; nb < 4; ++nb) { const int l = nb * 16 + fr; float m[4];
#pragma unroll
                for (int r = 0; r < 4; ++r) { const int s = mb * 16 + 4 * fq + r; const float v = acc[mb][nb][r] * __expf(al[nb] - as[r]) * ds[r]; m[r] = (s <= l) ? v : 0.f; m[r] += (s == l) ? dsk : 0.f; }
                v2u w; w.x = pk2(m[0], m[1]); w.y = pk2(m[2], m[3]);
                *(LAS v2u*)(mbuf + l * 144 + (mb * 16 + 4 * fq) * 2) = w; } }
    }
#pragma unroll
    for (int mb = 0; mb < 4; ++mb)
#pragma unroll
        for (int nb = 0; nb < 4; ++nb) acc[mb][nb] = (f32x4){0.f, 0.f, 0.f, 0.f};
#pragma unroll
    for (int ks = 0; ks < 4; ++ks)
#pragma unroll
        for (int mb = 0; mb < 4; ++mb) { const bf16x8 pvv = *(const bf16x8*)(pv + (size_t)(mb * 16 + fr) * 128 + 32 * ks + 8 * fq);
#pragma unroll
            for (int nb = 0; nb < 4; ++nb) acc[mb][nb] = mma16(pvv, cf[nb][ks], acc[mb][nb]); }
#pragma unroll
    for (int nb = 0; nb < 4; ++nb) { const float ea = __expf(al[nb]);
#pragma unroll
        for (int mb = 0; mb < 4; ++mb) acc[mb][nb] = acc[mb][nb] * ea; }
    LDS_WAIT();
#pragma unroll
    for (int ks = 0; ks < 2; ++ks) {
        bf16x8 mf[4];
#pragma unroll
        for (int nb = 0; nb < 4; ++nb) mf[nb] = *(const LAS bf16x8*)(mbuf + (nb * 16 + fr) * 144 + (32 * ks + 8 * fq) * 2);
#pragma unroll
        for (int mb = 0; mb < 4; ++mb) { const bf16x8 xv = *(const bf16x8*)(xsT + ((size_t)c * 1024 + h * 64 + mb * 16 + fr) * 64 + 32 * ks + 8 * fq);
#pragma unroll
            for (int nb = 0; nb < 4; ++nb) acc[mb][nb] = mma16(xv, mf[nb], acc[mb][nb]); }
    }
    float ss[4] = {0.f, 0.f, 0.f, 0.f};
#pragma unroll
    for (int nb = 0; nb < 4; ++nb)
#pragma unroll
        for (int mb = 0; mb < 4; ++mb) { const v2u zv = *(const v2u*)(U + (size_t)(t0 + nb * 16 + fr) * NU + 3072 + h * 64 + mb * 16 + 4 * fq);
            f32x4 y = acc[mb][nb]; y[0] *= silu_f(bflo(zv.x)); y[1] *= silu_f(bfhi(zv.x)); y[2] *= silu_f(bflo(zv.y)); y[3] *= silu_f(bfhi(zv.y));
            acc[mb][nb] = y; ss[nb] += (y[0] * y[0] + y[1] * y[1]) + (y[2] * y[2] + y[3] * y[3]); }
#pragma unroll
    for (int nb = 0; nb < 4; ++nb) { float s = ss[nb]; s += __shfl_xor(s, 16); s += __shfl_xor(s, 32); if (fq == 0) sred[hh * 64 + nb * 16 + fr] = s; }
    __syncthreads();
    if (F.tid < 64) { float s = 0.f;
#pragma unroll
        for (int w = 0; w < 8; ++w) s += sred[w * 64 + F.tid];
        srs[F.tid] = 1.f / sqrtf(s * (1.f / 512.f) + EPS); }
    __syncthreads();
    {
        const float* nw = a.in[IN_SNW] + h * 64;
#pragma unroll
        for (int nb = 0; nb < 4; ++nb) { const float r = srs[nb * 16 + fr];
#pragma unroll
            for (int mb = 0; mb < 4; ++mb) { const f32x4 n4 = *(const f32x4*)(nw + mb * 16 + 4 * fq); const f32x4 y = acc[mb][nb] * r * n4;
                v2u w; w.x = pk2(y[0], y[1]); w.y = pk2(y[2], y[3]);
                *(v2u*)(ymix + (size_t)(t0 + nb * 16 + fr) * D + 1024 + h * 64 + mb * 16 + 4 * fq) = w; } }
    }
    __syncthreads();
}

__device__ __forceinline__ void p6_unit(const Frame& F, const Args& a, int u) {
    const int t0 = u * 64, tid = F.tid, lane = F.lane, wave = F.wave;
    const float* X1 = a.out; const float* w2t = (const float*)(F.ws + WS_W2T); const float* bias2 = (const float*)(F.ws + WS_BIAS2);
    const float* mod = (const float*)(F.ws + WS_MOD);
    LAS float* spart = (LAS float*)F.lds;
    LAS float* sssq = (LAS float*)(F.lds + 98304);
    LAS float* srstd = (LAS float*)(F.lds + 100352);
    LAS int* seid = (LAS int*)(F.lds + 100608);
    LAS int* shist = (LAS int*)(F.lds + 101120);
    const int r16 = lane & 15, q = lane >> 4, k0 = wave * 256 + 4 * q;
    f32x4 acc[4][3];
#pragma unroll
    for (int rb = 0; rb < 4; ++rb)
#pragma unroll
        for (int cb = 0; cb < 3; ++cb) acc[rb][cb] = (f32x4){0.f, 0.f, 0.f, 0.f};
    float ssq[4] = {0.f, 0.f, 0.f, 0.f};
    const float* xrow = X1 + (size_t)(t0 + r16) * D + k0;
    const float* wrow = w2t + (size_t)r16 * D + k0;
#pragma unroll 2
    for (int s = 0; s < 16; ++s) {
        f32x4 av[4], bv[3];
#pragma unroll
        for (int rb = 0; rb < 4; ++rb) av[rb] = *(const f32x4*)(xrow + (size_t)rb * 16 * D + 16 * s);
#pragma unroll
        for (int cb = 0; cb < 3; ++cb) bv[cb] = *(const f32x4*)(wrow + (size_t)cb * 16 * D + 16 * s);
#pragma unroll
        for (int rb = 0; rb < 4; ++rb) ssq[rb] += (av[rb].x * av[rb].x + av[rb].y * av[rb].y) + (av[rb].z * av[rb].z + av[rb].w * av[rb].w);
#pragma unroll
        for (int e = 0; e < 4; ++e)
#pragma unroll
            for (int rb = 0; rb < 4; ++rb)
#pragma unroll
                for (int cb = 0; cb < 3; ++cb) acc[rb][cb] = __builtin_amdgcn_mfma_f32_16x16x4f32(av[rb][e], bv[cb][e], acc[rb][cb], 0, 0, 0);
    }
#pragma unroll
    for (int rb = 0; rb < 4; ++rb)
#pragma unroll
        for (int cb = 0; cb < 3; ++cb)
#pragma unroll
            for (int r = 0; r < 4; ++r) spart[(wave * 64 + rb * 16 + 4 * q + r) * 48 + cb * 16 + r16] = acc[rb][cb][r];
#pragma unroll
    for (int rb = 0; rb < 4; ++rb) { float s = ssq[rb]; s += __shfl_xor(s, 16); s += __shfl_xor(s, 32); if (q == 0) sssq[wave * 64 + rb * 16 + r16] = s; }
    if (tid < 32) shist[tid] = 0;
    __syncthreads();
    LAS float* slog = (LAS float*)(F.lds + 102400);
    for (int i = tid; i < 64 * 48; i += NTHR) { float v = 0.f;
#pragma unroll
        for (int w = 0; w < 8; ++w) v += spart[w * 64 * 48 + i];
        slog[i] = v; }
    if (tid < 64) { float s = 0.f;
#pragma unroll
        for (int w = 0; w < 8; ++w) s += sssq[w * 64 + tid];
        srstd[tid] = 1.f / sqrtf(s * (1.f / D) + EPS); }
    __syncthreads();
    if (tid < 64) {
        const float rstd = srstd[tid];
        float lg[36];
#pragma unroll
        for (int c = 0; c < 36; ++c) lg[c] = slog[tid * 48 + c] * rstd + bias2[c];
        int gi = 0; float gm = lg[0];
#pragma unroll
        for (int c = 1; c < 4; ++c) if (lg[c] > gm) { gm = lg[c]; gi = c; }
        float gs = 0.f;
#pragma unroll
        for (int c = 0; c < 4; ++c) gs += expf(lg[c] - gm);
        const float grp_p = 1.f / gs;
        float le[8];
#pragma unroll
        for (int j = 0; j < 8; ++j) { float v = lg[4 + j];
#pragma unroll
            for (int g2 = 1; g2 < 4; ++g2) v = (gi == g2) ? lg[4 + g2 * 8 + j] : v;
            le[j] = v; }
        int j1 = 0; float m1 = le[0];
#pragma unroll
        for (int j = 1; j < 8; ++j) if (le[j] > m1) { m1 = le[j]; j1 = j; }
        int j2 = -1; float m2 = -3.0e38f;
#pragma unroll
        for (int j = 0; j < 8; ++j) if (j != j1 && le[j] > m2) { m2 = le[j]; j2 = j; }
        const float e2 = expf(m2 - m1), w1 = grp_p / (1.f + e2), w2 = grp_p * e2 / (1.f + e2);
        const int ex1 = gi * 8 + j1, ex2 = gi * 8 + j2, t = t0 + tid;
        ((int*)(F.ws + WS_EID))[2 * t] = ex1; ((int*)(F.ws + WS_EID))[2 * t + 1] = ex2;
        ((float*)(F.ws + WS_EW))[2 * t] = w1; ((float*)(F.ws + WS_EW))[2 * t + 1] = w2;
        seid[2 * tid] = ex1; seid[2 * tid + 1] = ex2;
        __hip_atomic_fetch_add(&shist[ex1], 1, __ATOMIC_RELAXED, __HIP_MEMORY_SCOPE_WORKGROUP); __hip_atomic_fetch_add(&shist[ex2], 1, __ATOMIC_RELAXED, __HIP_MEMORY_SCOPE_WORKGROUP);
    }
    __syncthreads();
    if (tid < 32) ((int*)(F.ws + WS_BLKCNT))[u * 32 + tid] = shist[tid];
    if (tid < 128) { const int e = seid[tid]; int r = 0; for (int j = 0; j < tid; ++j) r += (seid[j] == e) ? 1 : 0; ((int*)(F.ws + WS_RANK))[2 * t0 + tid] = r; }
    {
        const float* n2w = a.in[IN_N2W]; const float* sh2 = mod + 3 * D; const float* sc2 = mod + 4 * D; bf16* H = (bf16*)(F.ws + WS_H);
        f32x4 av2[8], bv2[8];
#pragma unroll
        for (int j = 0; j < 8; ++j) { const int k = 4 * lane + 256 * j; const f32x4 w = *(const f32x4*)(n2w + k), s = *(const f32x4*)(sc2 + k); av2[j] = w * (s + 1.f); bv2[j] = *(const f32x4*)(sh2 + k); }
#pragma unroll 1
        for (int i = 0; i < 8; i += 2) {
            f32x4 xv[2][8];
#pragma unroll
            for (int u2 = 0; u2 < 2; ++u2)
#pragma unroll
                for (int j = 0; j < 8; ++j) xv[u2][j] = ((const f32x4*)(X1 + (size_t)(t0 + wave * 8 + i + u2) * D) + lane)[64 * j];
#pragma unroll
            for (int u2 = 0; u2 < 2; ++u2) { const int tok = wave * 8 + i + u2; const float rstd = srstd[tok]; v2u* o = (v2u*)(H + (size_t)(t0 + tok) * D) + lane;
#pragma unroll
                for (int j = 0; j < 8; ++j) { const f32x4 hv = xv[u2][j] * rstd * av2[j] + bv2[j]; v2u pw; pw.x = pk2(hv.x, hv.y); pw.y = pk2(hv.z, hv.w); o[64 * j] = pw; } }
        }
    }
    __syncthreads();
}

__device__ __forceinline__ void p7_unit(const Frame& F, int u) {
    const int t0 = u * 64, tid = F.tid;
    const int* blkcnt = (const int*)(F.ws + WS_BLKCNT); int* slot = (int*)(F.ws + WS_SLOT); const int* eid = (const int*)(F.ws + WS_EID);
    LAS int* stot = (LAS int*)F.lds;
    LAS int* sbef = (LAS int*)(F.lds + 128);
    LAS int* sbase = (LAS int*)(F.lds + 256);
    LAS int* sslot = (LAS int*)(F.lds + 512);
    LAS int* scnt = (LAS int*)(F.lds + 1024);
    for (int i = tid; i < NCHUNK * 32 / 4; i += NTHR) *(LAS v4u*)(scnt + 4 * i) = *(const v4u*)(blkcnt + 4 * i);
    __syncthreads();
    if (tid < 32) { int tot = 0, bef = 0;
#pragma unroll 8
        for (int b = 0; b < NCHUNK; ++b) { const int v = scnt[b * 32 + tid]; tot += v; bef += (b < u) ? v : 0; } stot[tid] = tot; sbef[tid] = bef; }
    __syncthreads();
    if (tid == 0) { int ps = 0; for (int e = 0; e < 32; ++e) { sbase[e] = ps + sbef[e];
            if (u == 0) { int* tile_e = (int*)(F.ws + WS_TILE); for (int i = ps >> 8; i < ((ps + ((stot[e] + 255) & ~255)) >> 8); ++i) tile_e[i] = e; }
            ps += (stot[e] + 255) & ~255; }
        if (u == 0) ((int*)(F.ws + WS_TILE))[192] = ps >> 8; }
    __syncthreads();
    if (tid < 128) { const int s = sbase[eid[2 * t0 + tid]] + ((const int*)(F.ws + WS_RANK))[2 * t0 + tid]; sslot[tid] = s; slot[2 * t0 + tid] = s; }
    __syncthreads();
    const bf16* H = (const bf16*)(F.ws + WS_H); bf16* hs = (bf16*)(F.ws + WS_U);
    for (int i = 0; i < 16; ++i) { const int a = F.wave * 16 + i, s = sslot[a]; const v4u* src = (const v4u*)(H + (size_t)(t0 + (a >> 1)) * D) + F.lane; v4u* dst = (v4u*)(hs + (size_t)s * D) + F.lane;
#pragma unroll
        for (int j = 0; j < 4; ++j) dst[64 * j] = src[64 * j]; }
    __syncthreads();
}

__device__ __forceinline__ void p10_rows(const Frame& F, const Args& a) {
    const float* mod = (const float*)(F.ws + WS_MOD); const float* g2 = mod + 5 * D; const float* fw = a.in[IN_FNW];
    const int* slot = (const int*)(F.ws + WS_SLOT); const float* ew = (const float*)(F.ws + WS_EW); const bf16* yb = (const bf16*)(F.ws + WS_YB);
    float dbg = 0.f;
#if defined(MK_DEBUG_CHECK)
    dbg = __builtin_bit_cast(float, __hip_atomic_load((unsigned*)(F.ws + WS_CTL) + CW_DBG, __ATOMIC_RELAXED, __HIP_MEMORY_SCOPE_AGENT));
#endif
    const int gw = F.bid * NWAVES + F.wave, NGW = F.G * NWAVES;
    f32x4 gv[8], fv[8];
#pragma unroll
    for (int j = 0; j < 8; ++j) { const int k = 4 * F.lane + 256 * j; gv[j] = *(const f32x4*)(g2 + k); fv[j] = *(const f32x4*)(fw + k); }
    f32x4 nx[8]; v2u ny0[8], ny1[8]; float nw0 = 0.f, nw1 = 0.f;
#define P10_LOAD(row_) do { const int s0_ = slot[2 * (row_)], s1_ = slot[2 * (row_) + 1]; nw0 = ew[2 * (row_)]; nw1 = ew[2 * (row_) + 1]; \
        const float* xr_ = a.out + (size_t)(row_) * D; const v2u* y0_ = (const v2u*)(yb + (size_t)s0_ * D) + F.lane; const v2u* y1_ = (const v2u*)(yb + (size_t)s1_ * D) + F.lane; \
        _Pragma("unroll") for (int j = 0; j < 8; ++j) { nx[j] = *(const f32x4*)(xr_ + 4 * F.lane + 256 * j); ny0[j] = y0_[64 * j]; ny1[j] = y1_[64 * j]; } } while (0)
    if (gw < T) P10_LOAD(gw);
    for (int row = gw; row < T; row += NGW) {
        f32x4 v[8]; float s = 0.f; const float w0 = nw0, w1 = nw1;
#pragma unroll
        for (int j = 0; j < 8; ++j) { const v2u a0 = ny0[j], a1 = ny1[j];
            f32x4 m; m.x = w0 * bflo(a0.x) + w1 * bflo(a1.x); m.y = w0 * bfhi(a0.x) + w1 * bfhi(a1.x); m.z = w0 * bflo(a0.y) + w1 * bflo(a1.y); m.w = w0 * bfhi(a0.y) + w1 * bfhi(a1.y);
            v[j] = nx[j] + gv[j] * m; s += (v[j].x * v[j].x + v[j].y * v[j].y) + (v[j].z * v[j].z + v[j].w * v[j].w); }
        if (row + NGW < T) P10_LOAD(row + NGW);
        const float rstd = (1.f + dbg) / sqrtf(wave_sum(s) * (1.f / D) + EPS);
        float* xr = a.out + (size_t)row * D;
#pragma unroll
        for (int j = 0; j < 8; ++j) *(f32x4*)(xr + 4 * F.lane + 256 * j) = v[j] * rstd * fv[j];
    }
#undef P10_LOAD
}

constexpr int NPHASES = 12;
__global__ void __launch_bounds__(NTHR, 2) mk_fwd(Args args) {
    extern __shared__ __attribute__((aligned(16))) unsigned char lds_raw[];
    Frame F;
    F.lds = (LAS unsigned char*)lds_raw;
    F.tid = threadIdx.x; F.lane = F.tid & 63; F.wave = __builtin_amdgcn_readfirstlane(F.tid >> 6);
    F.G = gridDim.x; F.bid = blockIdx.x; F.vcu = (F.G % 8 == 0) ? (F.bid % 8) * (F.G / 8) + F.bid / 8 : F.bid;
    F.ws = args.ws;
    volatile LAS unsigned* MISC = (volatile LAS unsigned*)(F.lds + MISC_OFF);
    if (F.tid < 16) MISC[F.tid] = 0u;
    __syncthreads();
    const int lo = args.ph_lo, hi = args.ph_hi;
    XcdBarrier bar; bar.bar = (unsigned*)(F.ws + WS_CTL) + CW_BAR + args.li * XCD_BAR_WORDS; bar.x = 0; bar.st = nullptr;
    if (hi - lo > 1) bar = xcd_barrier_post((unsigned*)(F.ws + WS_CTL) + CW_BAR + args.li * XCD_BAR_WORDS, MISC + 8);
#define IN(k) (lo <= (k) && (k) < hi)
#define SEAM(k) do { if (IN(k) && IN((k) + 1)) xcd_barrier(bar); } while (0)
    float* mod = (float*)(F.ws + WS_MOD);

    if (IN(0)) { p0_ada(F, args.in[IN_C], args.in[IN_WADA], args.in[IN_BADA], mod); p0_convert(F, args); }
    SEAM(0);
    if (IN(1)) { norm_rows(F, args.in[IN_X], args.in[IN_N1W], mod + D, mod, (bf16*)(F.ws + WS_H)); p1_router_prep(F, args); }
    SEAM(1);
    if (IN(2)) {
        pg8::Gemm g{(const pg8::bf16_t*)(F.ws + WS_H), (const pg8::bf16_t*)(F.ws + WS_WIN), T, N_IN_PAD, D, 0}; ConvOrder S; S.init(T, N_IN_PAD, F.G, F.bid);
        S.J = ConvJob{args.in[IN_WG], args.in[IN_WU], args.in[IN_WD], (bf16*)(F.ws + WS_WGU), (bf16*)(F.ws + WS_WD)};
        const int nmy = (S.nwg - F.bid + F.G - 1) / F.G, gwv = F.bid * NWAVES + F.wave, per = 65536 / (F.G * NWAVES);
        S.pos = nmy > 0 ? (((F.bid >> 3) % 5) < nmy ? ((F.bid >> 3) % 5) : nmy - 1) : -1; S.it0 = gwv * per; S.nit = per;
        pg8::EpiU E{(pg8::bf16_t*)(F.ws + WS_U), (float*)(F.ws + WS_UDT)};
        pg8::gemm_phase<pg8::EpiU, ConvOrder, true, true>(F.lds, g, S, E);
    }
    SEAM(2);
    if (IN(3)) { for (int c = F.bid; c < NCHUNK; c += F.G) p3_chunk(F, args, c); }
    SEAM(3);
    if (IN(4)) p_scan(F);
    SEAM(4);
    if (IN(5)) { for (int u = F.bid; u < 2 * NCHUNK; u += F.G) p4_unit(F, args, u >> 1, u & 1); }
    SEAM(5);
    if (IN(6)) {
        pg8::Gemm g{(const pg8::bf16_t*)(F.ws + WS_YMIX), (const pg8::bf16_t*)(F.ws + WS_WOUT), T, D, D, 0}; ConvOrder S; S.init(T, D, F.G, F.bid);
        S.J = ConvJob{args.in[IN_WG], args.in[IN_WU], args.in[IN_WD], (bf16*)(F.ws + WS_WGU), (bf16*)(F.ws + WS_WD)};
        const int nmy = (S.nwg - F.bid + F.G - 1) / F.G, gwv = F.bid * NWAVES + F.wave, per = 32768 / (F.G * NWAVES);
        S.pos = nmy > 0 ? (((F.bid >> 3) & 1) < nmy ? ((F.bid >> 3) & 1) : nmy - 1) : -1; S.it0 = 65536 + gwv * per; S.nit = per;
        pg8::EpiX1 E{args.in[IN_X], args.out, mod + 2 * D};
        pg8::gemm_phase<pg8::EpiX1, ConvOrder, true, true>(F.lds, g, S, E);
    }
    SEAM(6);
    if (IN(7)) { for (int u = F.bid; u < NCHUNK; u += F.G) p6_unit(F, args, u); }
    SEAM(7);
    if (IN(8)) { for (int u = F.bid; u < NCHUNK; u += F.G) p7_unit(F, u); }
    SEAM(8);
    if (IN(9)) {
        const int ntiles = __builtin_amdgcn_readfirstlane(__hip_atomic_load((int*)(F.ws + WS_TILE) + 192, __ATOMIC_RELAXED, __HIP_MEMORY_SCOPE_AGENT));
        pg8::Gemm g{(const pg8::bf16_t*)(F.ws + WS_U), (const pg8::bf16_t*)(F.ws + WS_WGU), ntiles * 256, 2048, D, (size_t)2048 * D * 2};
        pg8::MoeOrder S{(const int*)(F.ws + WS_TILE), ntiles * 8, 8, F.G, F.vcu};
        pg8::EpiHid E{(pg8::bf16_t*)(F.ws + WS_YMIX)};
        pg8::gemm_phase<pg8::EpiHid, pg8::MoeOrder, true, true, true>(F.lds, g, S, E);
    }
    SEAM(9);
    if (IN(10)) {
        const int ntiles = __builtin_amdgcn_readfirstlane(__hip_atomic_load((int*)(F.ws + WS_TILE) + 192, __ATOMIC_RELAXED, __HIP_MEMORY_SCOPE_AGENT));
        pg8::Gemm g{(const pg8::bf16_t*)(F.ws + WS_YMIX), (const pg8::bf16_t*)(F.ws + WS_WD), ntiles * 256, 2048, FF, (size_t)2048 * FF * 2};
        pg8::MoeOrder S{(const int*)(F.ws + WS_TILE), ntiles * 8, 8, F.G, F.vcu};
        pg8::EpiY E{(pg8::bf16_t*)(F.ws + WS_YB)};
        pg8::gemm_phase<pg8::EpiY, pg8::MoeOrder, true, true, true>(F.lds, g, S, E);
    }
    SEAM(10);
    if (IN(11)) p10_rows(F, args);
#undef IN
#undef SEAM
}

extern "C" void kernel_launch(void* const* d_in, const int* in_sizes, int n_in, void* d_out, int out_size, void* d_ws, size_t ws_size, hipStream_t stream) {
    static int grid = 0;
    if (grid == 0) {
        if (n_in != N_INPUTS || in_sizes[0] != T * D || out_size != T * D || ws_size < WS_END) { fprintf(stderr, "kernel_launch: unexpected shapes (n_in %d, in0 %d, out %d, ws %zu < %zu); nothing launched\n", n_in, n_in > 0 ? in_sizes[0] : -1, out_size, ws_size, (size_t)WS_END); grid = -1; return; }
        int dev = 0, cus = 0, per_cu = 0;
        if (hipGetDevice(&dev) != hipSuccess || hipDeviceGetAttribute(&cus, hipDeviceAttributeMultiprocessorCount, dev) != hipSuccess) { fprintf(stderr, "kernel_launch: device query failed\n"); grid = -1; return; }
        if (hipFuncSetAttribute((const void*)mk_fwd, hipFuncAttributeMaxDynamicSharedMemorySize, LDS_BYTES) != hipSuccess) { fprintf(stderr, "kernel_launch: hipFuncSetAttribute failed\n"); grid = -1; return; }
        if (hipOccupancyMaxActiveBlocksPerMultiprocessor(&per_cu, (const void*)mk_fwd, NTHR, LDS_BYTES) != hipSuccess || per_cu < 1) fprintf(stderr, "kernel_launch: note: occupancy query reports %d workgroups per CU\n", per_cu);
        (void)hipGetLastError();
        grid = cus;
    }
    if (grid < 0) return;
    if (hipMemsetAsync((char*)d_ws + WS_CTL, 0, CTL_ZERO_BYTES, stream) != hipSuccess) { fprintf(stderr, "kernel_launch: memset failed\n"); return; }
    Args a{};
    for (int i = 0; i < N_INPUTS; ++i) a.in[i] = (const float*)d_in[i];
    a.out = (float*)d_out; a.ws = (unsigned char*)d_ws;
#if defined(MK_PROBE) && MK_PROBE == 1
    static const int cuts[][2] = {{0, 1}, {0, 12}};
#elif defined(MK_PROBE) && MK_PROBE == 2
    static const int cuts[][2] = {{0, 3}, {1, 12}};
#elif defined(MK_PROBE) && MK_PROBE == 3
    static const int cuts[][2] = {{0, 6}, {3, 12}};
#elif defined(MK_PROBE) && MK_PROBE == 4
    static const int cuts[][2] = {{0, 8}, {6, 12}};
#elif defined(MK_PROBE) && MK_PROBE == 5
    static const int cuts[][2] = {{0, 11}, {9, 12}};
#elif defined(MK_PROBE) && MK_PROBE == 6
    static const int cuts[][2] = {{0, 4}, {3, 12}};
#elif defined(MK_PROBE) && MK_PROBE == 7
    static const int cuts[][2] = {{0, 6}, {5, 12}};
#elif defined(MK_PROBE) && MK_PROBE == 8
    static const int cuts[][2] = {{0, 8}, {7, 12}};
#elif defined(MK_PROBE) && MK_PROBE == 9
    static const int cuts[][2] = {{0, 7}, {6, 12}};
#elif defined(MK_PROBE) && MK_PROBE == 10
    static const int cuts[][2] = {{0, 9}, {8, 12}};
#elif defined(MK_PROBE) && MK_PROBE == 11
    static const int cuts[][2] = {{0, 5}, {12, 12}, {4, 12}};
#elif MK_N_LAUNCHES == 1
    static const int cuts[][2] = {{0, NPHASES}};
#else
    static const int cuts[][2] = {{0, 1}, {1, 2}, {2, 3}, {3, 4}, {4, 5}, {5, 6}, {6, 7}, {7, 8}, {8, 9}, {9, 10}, {10, 11}, {11, 12}};
#endif
    for (int li = 0; li < (int)(sizeof(cuts) / sizeof(cuts[0])); ++li) { a.ph_lo = cuts[li][0]; a.ph_hi = cuts[li][1]; a.li = li; hipLaunchKernelGGL(mk_fwd, dim3(grid), dim3(NTHR), LDS_BYTES, stream, a); }
    const hipError_t le = hipPeekAtLastError();
    if (le != hipSuccess) fprintf(stderr, "kernel_launch: launch failed: %s\n", hipGetErrorName(le));
}
```
